# Optimizing an MI355X kernel written in HIP

```python
import jax, jax.numpy as jnp
from jax import lax
import numpy as np

D_MODEL = 1024
BATCH = 8
SEQ = 2048
DEPTH = 2

GRID_W = 64
CTX_LEN = 256
MIX_W = D_MODEL
N_MIXERS = 4
GROUP_W = MIX_W // N_MIXERS
HEAD_DIM = 64
N_HEADS = GROUP_W // HEAD_DIM
GLA_DK = HEAD_DIM // 2
GLA_QK_W = N_HEADS * GLA_DK
GLA_RANK = 16
GLA_NORMALIZER = 16.0
GLA_CHUNK = 64
MLSTM_CHUNK = 64
CONV_K = 3
SGU_CHUNK = 128
D_FF = 256 * ((8 * D_MODEL // 3 + 255) // 256)
N_EXPERTS = 8
TOP_K = 2
D_FF_EXPERT = 7 * D_MODEL // 2
N_DENSE = (DEPTH + 1) // 2
N_MOE = DEPTH // 2
EPS = 1e-6
IN_SPLITS = (GLA_QK_W, GLA_QK_W, GROUP_W, GROUP_W, 2 * GLA_RANK,
             GROUP_W, GROUP_W, GROUP_W, GROUP_W, 4 * N_HEADS,
             GROUP_W, GROUP_W,
             GROUP_W)
REC_W = 2 * GLA_QK_W + 2 * GROUP_W + 2 * GLA_RANK + 4 * GROUP_W + 4 * N_HEADS
D_IN = REC_W + 3 * GROUP_W
F32 = jnp.float32

kernel_name = 'hybrid_parallel_mixer_dit_block'


def rmsnorm(x, g):
    x32 = x.astype(F32)
    y = x32 * lax.rsqrt(jnp.mean(x32 * x32, axis=-1, keepdims=True) + EPS)
    return (y * g.astype(F32)).astype(x.dtype)


def modulate(xn, shift, scale):
    return xn * (1 + scale) + shift


def heads(x, dh):
    b, t, _ = x.shape
    return x.reshape(b, t, -1, dh).transpose(0, 2, 1, 3)


def merge_heads(x):
    b, h, t, d = x.shape
    return x.transpose(0, 2, 1, 3).reshape(b, t, h * d)


def flip_t(x):
    return jnp.flip(x, axis=2)


def split_cols(p):
    parts, o = [], 0
    for s in IN_SPLITS:
        if o >= p.shape[-1]:
            break
        parts.append(p[..., o:o + s])
        o += s
    return parts


def conv2d_grid(x, w, rows, cols):
    b, t, ch = x.shape
    y = lax.conv_general_dilated(x.reshape(b, rows, cols, ch), w[:, :, None, :].astype(x.dtype),
                                 window_strides=(1, 1), padding='SAME',
                                 dimension_numbers=('NHWC', 'HWIO', 'NHWC'), feature_group_count=ch)
    return y.reshape(b, t, ch)


def gla_scan(q, k, v, log_a, s0, with_output):
    b, h, t, dk = q.shape
    dv = v.shape[-1]
    n = t // GLA_CHUNK
    q, k, log_a = (a.reshape(b, h, n, GLA_CHUNK, dk) for a in (q, k, log_a))
    v = v.reshape(b, h, n, GLA_CHUNK, dv)
    cum = jnp.cumsum(log_a, axis=3)
    cum_last = cum[:, :, :, -1:, :]
    upd = jnp.einsum('bhnld,bhnlv->bhndv', k * jnp.exp(cum_last - cum), v)
    decay = jnp.exp(cum_last[:, :, :, 0, :])

    def step(s, inp):
        d, u = inp
        return d[..., None] * s + u, s

    s_fin, s_prev = lax.scan(step, s0, (jnp.moveaxis(decay, 2, 0), jnp.moveaxis(upd, 2, 0)))
    if not with_output:
        return None, s_fin
    s_prev = jnp.moveaxis(s_prev, 0, 2)
    q_dec = q * jnp.exp(cum)
    mask = jnp.tril(jnp.ones((GLA_CHUNK, GLA_CHUNK), dtype=bool))
    scores = jnp.where(mask, jnp.einsum('bhnld,bhnsd->bhnls', q_dec, k * jnp.exp(-cum)), 0.0)
    o = jnp.einsum('bhnls,bhnsv->bhnlv', scores, v) + jnp.einsum('bhnld,bhndv->bhnlv', q_dec, s_prev)
    return o.reshape(b, h, t, dv), s_fin


def mlstm_scan(q, k, v, ig, lf, state, with_output):
    b, h, t, dk = q.shape
    dv = v.shape[-1]
    n = t // MLSTM_CHUNK
    L = MLSTM_CHUNK
    q, k = (a.reshape(b, h, n, L, dk) for a in (q, k))
    v = v.reshape(b, h, n, L, dv)
    ig, lf = (a.reshape(b, h, n, L) for a in (ig, lf))
    cum = jnp.cumsum(lf, axis=3)
    cum_last = cum[..., -1]
    w_end = cum_last[..., None] - cum + ig
    m_chunk = jnp.max(w_end, axis=-1)
    w_k = jnp.exp(w_end - m_chunk[..., None])
    upd_c = jnp.einsum('bhnl,bhnld,bhnlv->bhndv', w_k, k, v)
    upd_n = jnp.einsum('bhnl,bhnld->bhnd', w_k, k)

    def step(carry, inp):
        c_st, n_st, m_st = carry
        fl, mc, uc, un = inp
        m_new = jnp.maximum(fl + m_st, mc)
        a = jnp.exp(fl + m_st - m_new)
        g = jnp.exp(mc - m_new)
        c_new = a[..., None, None] * c_st + g[..., None, None] * uc
        n_new = a[..., None] * n_st + g[..., None] * un
        return (c_new, n_new, m_new), (c_st, n_st, m_st)

    xs = tuple(jnp.moveaxis(a, 2, 0) for a in (cum_last, m_chunk, upd_c, upd_n))
    fin, prev = lax.scan(step, state, xs)
    if not with_output:
        return None, fin
    c_prev, n_prev, m_prev = (jnp.moveaxis(a, 0, 2) for a in prev)
    mask = jnp.tril(jnp.ones((L, L), dtype=bool))
    d_log = jnp.where(mask, cum[..., :, None] - cum[..., None, :] + ig[..., None, :], -jnp.inf)
    inter_log = cum + m_prev[..., None]
    m_row = jnp.maximum(inter_log, jnp.max(d_log, axis=-1))
    s = jnp.exp(d_log - m_row[..., None]) * jnp.einsum('bhnld,bhnsd->bhnls', q, k)
    w_int = jnp.exp(inter_log - m_row)
    num = jnp.einsum('bhnls,bhnsv->bhnlv', s, v) + w_int[..., None] * jnp.einsum('bhnld,bhndv->bhnlv', q, c_prev)
    den = jnp.sum(s, axis=-1) + w_int * jnp.einsum('bhnld,bhnd->bhnl', q, n_prev)
    out = num / jnp.maximum(jnp.abs(den), jnp.exp(-m_row))[..., None]
    return out.reshape(b, h, t, dv), fin


def gla_inputs(parts, w_lr, b_lr):
    b, t, _ = parts[0].shape
    q = heads(parts[0], GLA_DK) * GLA_DK ** -0.5
    k = heads(parts[1], GLA_DK)
    v = heads(parts[2], HEAD_DIM)
    lr = parts[4].reshape(b, t, 2, GLA_RANK)
    la = jax.nn.log_sigmoid(jnp.einsum('btjr,jrd->jbtd', lr, w_lr) + b_lr[:, None, None, :]) / GLA_NORMALIZER
    return q, k, v, heads(la[0], GLA_DK), heads(la[1], GLA_DK)


def gla_output(o, g, norm_g):
    o = o * lax.rsqrt(jnp.mean(o * o, axis=-1, keepdims=True) + EPS)
    return merge_heads(o) * norm_g * jax.nn.silu(g)


def gla_mixer(parts, parts_c, w_lr, b_lr, norm_g, ctx_out):
    q, k, v, la_f, la_b = gla_inputs(parts, w_lr, b_lr)
    qc, kc, vc, lac_f, lac_b = gla_inputs(parts_c, w_lr, b_lr)
    s0 = jnp.zeros(qc.shape[:2] + (GLA_DK, HEAD_DIM), F32)
    oc_f, s_f = gla_scan(qc, kc, vc, lac_f, s0, ctx_out)
    oc_b, s_b = gla_scan(flip_t(qc), flip_t(kc), flip_t(vc), flip_t(lac_b), s0, ctx_out)
    o_f, _ = gla_scan(q, k, v, la_f, s_f, True)
    o_b, _ = gla_scan(flip_t(q), flip_t(k), flip_t(v), flip_t(la_b), s_b, True)
    out = gla_output(o_f + flip_t(o_b), parts[3], norm_g)
    out_c = gla_output(oc_f + flip_t(oc_b), parts_c[3], norm_g) if ctx_out else None
    return out, out_c


def mlstm_inputs(parts, conv_w, gate_b, rows, cols):
    b, t, _ = parts[5].shape
    qk = jax.nn.silu(conv2d_grid(jnp.concatenate([parts[5], parts[6]], axis=-1), conv_w, rows, cols))
    q = heads(qk[..., :GROUP_W], HEAD_DIM)
    k = heads(qk[..., GROUP_W:], HEAD_DIM) * HEAD_DIM ** -0.5
    v = heads(parts[7], HEAD_DIM)
    gates = (parts[9].reshape(b, t, 2, 2, N_HEADS) + gate_b).transpose(2, 3, 0, 4, 1)
    return (q, k, v, gates[0, 0], jax.nn.log_sigmoid(gates[0, 1]),
            gates[1, 0], jax.nn.log_sigmoid(gates[1, 1]))


def mlstm_mixer(parts, parts_c, conv_w, gate_b, rows, ctx_out):
    q, k, v, i_f, f_f, i_b, f_b = mlstm_inputs(parts, conv_w, gate_b, rows, GRID_W)
    qc, kc, vc, ic_f, fc_f, ic_b, fc_b = mlstm_inputs(parts_c, conv_w, gate_b, 1, parts_c[5].shape[1])
    nb, nh = qc.shape[:2]
    st0 = (jnp.zeros((nb, nh, HEAD_DIM, HEAD_DIM), F32), jnp.zeros((nb, nh, HEAD_DIM), F32),
           jnp.zeros((nb, nh), F32))
    hc_f, st_f = mlstm_scan(qc, kc, vc, ic_f, fc_f, st0, ctx_out)
    hc_b, st_b = mlstm_scan(flip_t(qc), flip_t(kc), flip_t(vc), flip_t(ic_b), flip_t(fc_b), st0, ctx_out)
    h_f, _ = mlstm_scan(q, k, v, i_f, f_f, st_f, True)
    h_b, _ = mlstm_scan(flip_t(q), flip_t(k), flip_t(v), flip_t(i_b), flip_t(f_b), st_b, True)
    out = jax.nn.sigmoid(parts[8]) * merge_heads(h_f + flip_t(h_b))
    out_c = jax.nn.sigmoid(parts_c[8]) * merge_heads(hc_f + flip_t(hc_b)) if ctx_out else None
    return out, out_c


def sgu(u, v, w_s, b_s):
    b, t, _ = v.shape
    mu = jnp.mean(v, axis=-1, keepdims=True)
    vn = (v - mu) * lax.rsqrt(jnp.mean((v - mu) ** 2, axis=-1, keepdims=True) + EPS)
    vg = vn.reshape(b, t // SGU_CHUNK, SGU_CHUNK, N_HEADS, HEAD_DIM)
    mixed = jnp.einsum('gls,bnsgc->bnlgc', w_s, vg) + b_s.T[:, :, None]
    return u * mixed.reshape(b, t, GROUP_W)


def fourier_mix(u):
    b, t, _ = u.shape
    ug = u.astype(F32).reshape(b, t, N_HEADS, HEAD_DIM)
    return jnp.fft.fft2(ug, axes=(1, 3), norm='ortho').real.reshape(b, t, GROUP_W)


def token_mixers(h, hc, w_in, gla_w_lr, gla_b_lr, gla_norm_g, mlstm_conv, mlstm_gate_b, sgu_w, sgu_b, ctx_out):
    rows = h.shape[1] // GRID_W
    parts = split_cols((h @ w_in).astype(F32))
    parts_c = split_cols((hc @ (w_in if ctx_out else w_in[:, :REC_W])).astype(F32))
    gla, gla_c = gla_mixer(parts, parts_c, gla_w_lr, gla_b_lr, gla_norm_g, ctx_out)
    ml, ml_c = mlstm_mixer(parts, parts_c, mlstm_conv, mlstm_gate_b, rows, ctx_out)
    sg = sgu(parts[10], parts[11], sgu_w, sgu_b)
    fo = fourier_mix(parts[12])
    mix = jnp.concatenate([gla, ml, sg, fo], axis=-1).astype(h.dtype)
    if not ctx_out:
        return mix, None
    sg_c = sgu(parts_c[10], parts_c[11], sgu_w, sgu_b)
    fo_c = fourier_mix(parts_c[12])
    mix_c = jnp.concatenate([gla_c, ml_c, sg_c, fo_c], axis=-1).astype(hc.dtype)
    return mix, mix_c


def swiglu(h, w_g, w_u, w_d):
    return (jax.nn.silu(h @ w_g) * (h @ w_u)) @ w_d


def moe_ffn(h, w_router, w_g, w_u, w_d):
    b, t, d = h.shape
    hf = h.reshape(-1, d)
    logits = (hf @ w_router).astype(F32)
    top_v, top_i = lax.top_k(logits, TOP_K)
    gates = jax.nn.softmax(top_v, axis=-1)
    flat_e = top_i.reshape(-1)
    order = jnp.argsort(flat_e)
    tok = order // TOP_K
    xs = hf[tok]
    sizes = jnp.bincount(flat_e, length=N_EXPERTS).astype(jnp.int32)
    g = lax.ragged_dot(xs, w_g, sizes)
    u = lax.ragged_dot(xs, w_u, sizes)
    y = lax.ragged_dot(jax.nn.silu(g) * u, w_d, sizes)
    y = y * gates.reshape(-1)[order][:, None].astype(y.dtype)
    return jnp.zeros_like(hf).at[tok].add(y).reshape(b, t, d)


def setup_inputs(seed: int = 0) -> dict:
    key = jax.random.key(seed)
    ks = jax.random.split(key, 25)
    nrm = jax.random.normal
    s = D_MODEL ** -0.5
    fbias = jnp.zeros((DEPTH, 2, 2, N_HEADS), F32).at[:, :, 1, :].set(jnp.linspace(3.0, 6.0, N_HEADS))
    return {
        'x': nrm(ks[0], (BATCH, SEQ, D_MODEL), F32),
        'c': nrm(ks[1], (BATCH, D_MODEL), F32),
        'ctx': nrm(ks[2], (BATCH, CTX_LEN, D_MODEL), F32),
        'c_ctx': nrm(ks[3], (D_MODEL,), F32),
        'w_ada': nrm(ks[4], (DEPTH, D_MODEL, 6 * D_MODEL), F32) * s,
        'b_ada': 0.02 * nrm(ks[5], (DEPTH, 6 * D_MODEL), F32),
        'norm_mix_g': 1.0 + 0.1 * nrm(ks[6], (DEPTH, D_MODEL), F32),
        'norm_ffn_g': 1.0 + 0.1 * nrm(ks[7], (DEPTH, D_MODEL), F32),
        'w_in': nrm(ks[8], (DEPTH, D_MODEL, D_IN), F32) * s,
        'w_out': nrm(ks[9], (DEPTH, MIX_W, D_MODEL), F32) * MIX_W ** -0.5,
        'gla_w_lr': nrm(ks[10], (DEPTH, 2, GLA_RANK, GLA_QK_W), F32) * GLA_RANK ** -0.5,
        'gla_b_lr': 0.1 * nrm(ks[11], (DEPTH, 2, GLA_QK_W), F32),
        'gla_norm_g': 1.0 + 0.1 * nrm(ks[12], (DEPTH, GROUP_W), F32),
        'mlstm_conv': nrm(ks[13], (DEPTH, CONV_K, CONV_K, 2 * GROUP_W), F32) / CONV_K,
        'mlstm_gate_b': fbias + 0.1 * nrm(ks[14], (DEPTH, 2, 2, N_HEADS), F32),
        'sgu_w': nrm(ks[15], (DEPTH, N_HEADS, SGU_CHUNK, SGU_CHUNK), F32) * SGU_CHUNK ** -0.5,
        'sgu_b': 1.0 + 0.1 * nrm(ks[16], (DEPTH, N_HEADS, SGU_CHUNK), F32),
        'ffn_w_gate': nrm(ks[17], (N_DENSE, D_MODEL, D_FF), F32) * s,
        'ffn_w_up': nrm(ks[18], (N_DENSE, D_MODEL, D_FF), F32) * s,
        'ffn_w_down': nrm(ks[19], (N_DENSE, D_FF, D_MODEL), F32) * D_FF ** -0.5,
        'moe_router': nrm(ks[20], (N_MOE, D_MODEL, N_EXPERTS), F32) * s,
        'moe_w_gate': nrm(ks[21], (N_MOE, N_EXPERTS, D_MODEL, D_FF_EXPERT), F32) * s,
        'moe_w_up': nrm(ks[22], (N_MOE, N_EXPERTS, D_MODEL, D_FF_EXPERT), F32) * s,
        'moe_w_down': nrm(ks[23], (N_MOE, N_EXPERTS, D_FF_EXPERT, D_MODEL), F32) * D_FF_EXPERT ** -0.5,
        'final_norm_g': 1.0 + 0.1 * nrm(ks[24], (D_MODEL,), F32),
    }


def reference(x, c, ctx, c_ctx, w_ada, b_ada, norm_mix_g, norm_ffn_g, w_in, w_out, gla_w_lr, gla_b_lr,
              gla_norm_g, mlstm_conv, mlstm_gate_b, sgu_w, sgu_b, ffn_w_gate, ffn_w_up, ffn_w_down,
              moe_router, moe_w_gate, moe_w_up, moe_w_down, final_norm_g):
    xc = ctx
    for l in range(DEPTH):
        ctx_out = l < DEPTH - 1
        mod = jnp.split(jax.nn.silu(c) @ w_ada[l] + b_ada[l], 6, axis=-1)
        mod_c = jnp.split(jax.nn.silu(c_ctx) @ w_ada[l] + b_ada[l], 6, axis=-1)
        sh1, sc1, g1, sh2, sc2, g2 = (m[:, None, :] for m in mod)
        csh1, csc1, cg1, csh2, csc2, cg2 = mod_c
        h = modulate(rmsnorm(x, norm_mix_g[l]), sh1, sc1)
        hc = modulate(rmsnorm(xc, norm_mix_g[l]), csh1, csc1)
        mix, mix_c = token_mixers(h, hc, w_in[l], gla_w_lr[l], gla_b_lr[l], gla_norm_g[l], mlstm_conv[l],
                                  mlstm_gate_b[l], sgu_w[l], sgu_b[l], ctx_out)
        x = x + g1 * (mix @ w_out[l])
        if ctx_out:
            xc = xc + cg1 * (mix_c @ w_out[l])
        h = modulate(rmsnorm(x, norm_ffn_g[l]), sh2, sc2)
        i = l // 2
        if l % 2 == 0:
            x = x + g2 * swiglu(h, ffn_w_gate[i], ffn_w_up[i], ffn_w_down[i])
            if ctx_out:
                hc = modulate(rmsnorm(xc, norm_ffn_g[l]), csh2, csc2)
                xc = xc + cg2 * swiglu(hc, ffn_w_gate[i], ffn_w_up[i], ffn_w_down[i])
        else:
            x = x + g2 * moe_ffn(h, moe_router[i], moe_w_gate[i], moe_w_up[i], moe_w_down[i])
            if ctx_out:
                hc = modulate(rmsnorm(xc, norm_ffn_g[l]), csh2, csc2)
                xc = xc + cg2 * moe_ffn(hc, moe_router[i], moe_w_gate[i], moe_w_up[i], moe_w_down[i])
    return rmsnorm(x, final_norm_g)
```

```cpp
#include <hip/hip_runtime.h>
#include <cstdio>
#include <cstdint>

#ifndef MK_ONE_LAUNCH
#define MK_ONE_LAUNCH 1
#endif

namespace pg8 {
#define PG8_LAS __attribute__((address_space(3)))
typedef unsigned short bf16_t;
typedef short bf16x8 __attribute__((ext_vector_type(8)));
typedef float f32x4 __attribute__((ext_vector_type(4)));
typedef float f32x2 __attribute__((ext_vector_type(2)));
typedef unsigned u32x4 __attribute__((ext_vector_type(4)));
constexpr int BM = 256, BK = 64, HALF = 128, HTB = HALF * BK * 2, STAGE_BYTES = 8 * HTB, NXCD = 8, WGM = 8;

__host__ __device__ __forceinline__ int lds_byte(int r, int c) { const int st = (r >> 4) * 2 + (c >> 5), rr = r & 15, cc = c & 31, ob = rr * 64 + cc * 2; return st * 1024 + (ob ^ (((ob >> 9) & 1) << 5)); }
__host__ __device__ __forceinline__ void stage_rc(int b, int& R, int& C) { const int st = b / 1024, sb = b % 1024, swz = sb ^ (((sb >> 9) & 1) << 5); R = (st >> 1) * 16 + swz / 64; C = (st & 1) * 32 + (swz % 64) / 2; }
__host__ __device__ __forceinline__ int perm32(int rho) { const int n = rho >> 4, i = rho & 15; return 8 * (i >> 2) + 4 * n + (i & 3); }

struct Unit { int pm, pn, z; };

struct StaticOrder {
    int nM, nN, nwg, G, c;
    __host__ __device__ void init(int nM_, int nN_, int G_, int c_) { nM = nM_; nN = nN_; nwg = nM * nN; G = G_; c = c_; }
    __host__ __device__ bool next(int i, Unit& u) const {
        const long L = (long)i * G + c; if (L >= nwg) return false;
        int wgid = (int)L; { const int q = nwg / NXCD, r = nwg % NXCD, xcd = wgid % NXCD, off = wgid / NXCD; wgid = (xcd < r ? xcd * (q + 1) : r * (q + 1) + (xcd - r) * q) + off; }
        const int nig = WGM * nN, gid = wgid / nig, fm = gid * WGM, gsz = (nM - fm) < WGM ? (nM - fm) : WGM;
        u.pm = fm + ((wgid % nig) % gsz); u.pn = (wgid % nig) / gsz; u.z = 0; return true;
    }
};

typedef __bf16 bf16v2_t __attribute__((ext_vector_type(2)));
__device__ __forceinline__ unsigned cvt_pk_safe(float lo, float hi) { const bf16v2_t v = __builtin_convertvector((f32x2){lo, hi}, bf16v2_t); return __builtin_bit_cast(unsigned, v); }
__device__ __forceinline__ unsigned cvt_pk_bf16(float lo, float hi) { return cvt_pk_safe(lo, hi); }

template <class Epi, class Sched, bool ALIGN_EPI = false, bool SP2 = false>
__device__ __forceinline__ void gemm_phase(PG8_LAS unsigned char* lds, const int K, const Sched& S, const Epi& E, const int pitch_ = 0) {
    const int tid = threadIdx.x, wid = __builtin_amdgcn_readfirstlane(tid >> 6), lane = tid & 63, wr = wid >> 2, wc = wid & 3, fr = lane & 15, fq = lane >> 4;
    const int nt = K / BK, pitch = pitch_ ? pitch_ : K;
    unsigned voffA[2], voffB[2];
#pragma unroll
    for (int i = 0; i < 2; ++i) { int R, C; stage_rc(tid * 16 + i * 8192, R, C); const int Rb = Epi::PERM ? ((R & ~31) + perm32(R & 31)) : R;
        voffA[i] = (unsigned)(R * pitch + C) * 2u; voffB[i] = (unsigned)(Rb * pitch + C) * 2u; }
    const size_t kstep = (size_t)(BK * 2);
    const size_t hstep = (size_t)HALF * pitch * 2;
    const unsigned ldsw = (unsigned)wid * 1024u;
    const int aoff = lds_byte(wr * 64 + fr, fq * 8), boff = lds_byte(wc * 32 + fr, fq * 8);
#define PG8_SA(b, h) (((b) * 2 + (h)) * HTB)
#define PG8_SB(b, h) ((4 + (b) * 2 + (h)) * HTB)
#define PG8_STAGE(bufoff, gbase, voff) do { _Pragma("unroll") for (int _i = 0; _i < 2; ++_i) \
        __builtin_amdgcn_global_load_lds((const unsigned*)((const char*)(gbase) + (voff)[_i]), (PG8_LAS unsigned*)(lds + (bufoff) + ldsw + _i * 8192), 16, 0, 0); } while (0)
#define PG8_LDA(dst, b, h) do { _Pragma("unroll") for (int m = 0; m < 4; ++m) _Pragma("unroll") for (int k = 0; k < 2; ++k) dst[m][k] = *(const PG8_LAS bf16x8*)(lds + PG8_SA(b, h) + aoff + m * 2048 + k * 1024); } while (0)
#define PG8_LDB(dst, b, h) do { _Pragma("unroll") for (int n = 0; n < 2; ++n) _Pragma("unroll") for (int k = 0; k < 2; ++k) dst[n][k] = *(const PG8_LAS bf16x8*)(lds + PG8_SB(b, h) + boff + n * 2048 + k * 1024); } while (0)
#define PG8_MMA(ai, bj, At, Bt) do { __builtin_amdgcn_s_setprio(1); _Pragma("unroll") for (int m = 0; m < 4; ++m) _Pragma("unroll") for (int n = 0; n < 2; ++n) _Pragma("unroll") for (int k = 0; k < 2; ++k) \
        acc[ai][bj][m][n] = __builtin_amdgcn_mfma_f32_16x16x32_bf16(Bt[n][k], At[m][k], acc[ai][bj][m][n], 0, 0, 0); __builtin_amdgcn_s_setprio(0); } while (0)
#define PG8_WAIT_V(n) asm volatile("s_waitcnt vmcnt(" #n ")" ::: "memory")
#define PG8_WAIT_L(n) asm volatile("s_waitcnt lgkmcnt(" #n ")" ::: "memory")
#define PG8_BAR __builtin_amdgcn_s_barrier()
#define PG8_SCHED __builtin_amdgcn_sched_barrier(0)
    Unit cur, nxt; int ui = 0;
    if (!S.next(0, cur)) return;
    f32x4 acc[2][2][4][2];
#pragma unroll
    for (int a = 0; a < 2; ++a)
#pragma unroll
        for (int b = 0; b < 2; ++b)
#pragma unroll
            for (int m = 0; m < 4; ++m)
#pragma unroll
                for (int n = 0; n < 2; ++n) acc[a][b][m][n] = (f32x4){0.f, 0.f, 0.f, 0.f};
    bf16x8 At[4][2], B0[2][2], B1[2][2];
    const char* cA = S.aptr(cur); const char* cB = S.bptr(cur);
    if constexpr (SP2) {
        PG8_STAGE(PG8_SB(0, 0), cB, voffB); PG8_STAGE(PG8_SB(0, 1), cB + hstep, voffB); PG8_STAGE(PG8_SA(0, 0), cA, voffA); PG8_STAGE(PG8_SA(0, 1), cA + hstep, voffA);
        if (wr == 1) PG8_BAR;
        PG8_WAIT_V(2); PG8_BAR;
        PG8_STAGE(PG8_SB(1, 0), cB + kstep, voffB); PG8_STAGE(PG8_SA(1, 0), cA + kstep, voffA); PG8_STAGE(PG8_SB(1, 1), cB + hstep + kstep, voffB);
        PG8_WAIT_V(6); PG8_BAR;
    } else {
        PG8_STAGE(PG8_SB(0, 0), cB, voffB); PG8_STAGE(PG8_SA(0, 0), cA, voffA); PG8_STAGE(PG8_SB(0, 1), cB + hstep, voffB); PG8_STAGE(PG8_SA(0, 1), cA + hstep, voffA);
        if (wr == 1) PG8_BAR;
        PG8_WAIT_V(4); PG8_BAR;
        PG8_STAGE(PG8_SB(1, 0), cB + kstep, voffB); PG8_STAGE(PG8_SA(1, 0), cA + kstep, voffA); PG8_STAGE(PG8_SB(1, 1), cB + hstep + kstep, voffB);
        PG8_WAIT_V(6); PG8_BAR;
    }
    for (;;) {
        const bool has_next = S.next(ui + 1, nxt);
        const char* nA = has_next ? S.aptr(nxt) : cA; const char* nB = has_next ? S.bptr(nxt) : cB;
        for (int t = 0; t < nt; t += 2) {
            const bool last = (t == nt - 2);
            const char* a1 = cA + (size_t)(t + 1) * kstep;
            const char* a2 = last ? nA : cA + (size_t)(t + 2) * kstep; const char* b2 = last ? nB : cB + (size_t)(t + 2) * kstep;
            const char* a3 = a2 + kstep; const char* b3 = b2 + kstep;
            if constexpr (SP2) {
            PG8_LDB(B0, 0, 0); PG8_LDB(B1, 0, 1); PG8_SCHED; PG8_LDA(At, 0, 0); PG8_STAGE(PG8_SA(1, 1), a1 + hstep, voffA);
            PG8_WAIT_V(8); PG8_WAIT_L(0); PG8_BAR; PG8_MMA(0, 0, At, B0); PG8_MMA(0, 1, At, B1); PG8_BAR; PG8_SCHED;
            PG8_LDA(At, 0, 1); PG8_STAGE(PG8_SB(0, 0), b2, voffB); PG8_STAGE(PG8_SB(0, 1), b2 + hstep, voffB); PG8_STAGE(PG8_SA(0, 0), a2, voffA);
            PG8_WAIT_V(8); PG8_WAIT_L(0); PG8_BAR; PG8_MMA(1, 0, At, B0); PG8_MMA(1, 1, At, B1); PG8_BAR; PG8_SCHED;
            PG8_LDB(B0, 1, 0); PG8_LDB(B1, 1, 1); PG8_SCHED; PG8_LDA(At, 1, 0); PG8_STAGE(PG8_SA(0, 1), a2 + hstep, voffA);
            PG8_WAIT_V(8); PG8_WAIT_L(0); PG8_BAR; PG8_MMA(0, 0, At, B0); PG8_MMA(0, 1, At, B1); PG8_BAR; PG8_SCHED;
            PG8_LDA(At, 1, 1); PG8_STAGE(PG8_SB(1, 0), b3, voffB); PG8_STAGE(PG8_SB(1, 1), b3 + hstep, voffB); PG8_STAGE(PG8_SA(1, 0), a3, voffA);
            PG8_WAIT_V(8); PG8_WAIT_L(0); PG8_BAR; PG8_MMA(1, 0, At, B0); PG8_MMA(1, 1, At, B1); PG8_BAR; PG8_SCHED;
            } else {
            PG8_LDB(B0, 0, 0); PG8_SCHED; PG8_LDA(At, 0, 0); PG8_STAGE(PG8_SA(1, 1), a1 + hstep, voffA);
            PG8_WAIT_L(8); PG8_BAR; PG8_WAIT_L(0); PG8_MMA(0, 0, At, B0); PG8_BAR; PG8_SCHED;
            PG8_LDB(B1, 0, 1); PG8_STAGE(PG8_SB(0, 0), b2, voffB);
            PG8_BAR; PG8_WAIT_L(0); PG8_MMA(0, 1, At, B1); PG8_BAR;
            PG8_LDA(At, 0, 1); PG8_STAGE(PG8_SA(0, 0), a2, voffA);
            PG8_BAR; PG8_WAIT_L(0); PG8_MMA(1, 0, At, B0); PG8_BAR; PG8_SCHED;
            PG8_STAGE(PG8_SB(0, 1), b2 + hstep, voffB);
            PG8_WAIT_V(6); PG8_BAR; PG8_MMA(1, 1, At, B1); PG8_BAR;
            PG8_LDB(B0, 1, 0); PG8_SCHED; PG8_LDA(At, 1, 0); PG8_STAGE(PG8_SA(0, 1), a2 + hstep, voffA);
            PG8_WAIT_L(8); PG8_BAR; PG8_WAIT_L(0); PG8_MMA(0, 0, At, B0); PG8_BAR; PG8_SCHED;
            PG8_LDB(B1, 1, 1); PG8_STAGE(PG8_SB(1, 0), b3, voffB);
            PG8_BAR; PG8_WAIT_L(0); PG8_MMA(0, 1, At, B1); PG8_BAR;
            PG8_LDA(At, 1, 1); PG8_STAGE(PG8_SA(1, 0), a3, voffA);
            PG8_BAR; PG8_WAIT_L(0); PG8_MMA(1, 0, At, B0); PG8_BAR; PG8_SCHED;
            PG8_STAGE(PG8_SB(1, 1), b3 + hstep, voffB);
            PG8_WAIT_V(6); PG8_BAR; PG8_MMA(1, 1, At, B1); PG8_BAR;
            }
        }
        if constexpr (ALIGN_EPI) { if (wr == 0) PG8_BAR; }
        E(acc, cur, wr, wc, fr, fq);
        if (!has_next) break;
#pragma unroll
        for (int a = 0; a < 2; ++a)
#pragma unroll
            for (int b = 0; b < 2; ++b)
#pragma unroll
                for (int m = 0; m < 4; ++m)
#pragma unroll
                    for (int n = 0; n < 2; ++n) acc[a][b][m][n] = (f32x4){0.f, 0.f, 0.f, 0.f};
        cur = nxt; cA = nA; cB = nB; ++ui;
        if constexpr (ALIGN_EPI) { if (wr == 1) PG8_BAR; }
    }
    PG8_WAIT_V(0);
    if constexpr (!ALIGN_EPI) { if (wr == 0) PG8_BAR; }
    PG8_BAR;
#undef PG8_SA
#undef PG8_SB
#undef PG8_STAGE
#undef PG8_LDA
#undef PG8_LDB
#undef PG8_MMA
#undef PG8_WAIT_V
#undef PG8_WAIT_L
#undef PG8_BAR
#undef PG8_SCHED
}
}

#ifndef PG8_SP2
#define PG8_SP2 true
#endif
#ifndef PG8_ALIGN
#define PG8_ALIGN true
#endif

constexpr int NWAVES = 8;
constexpr int D = 1024, NB = 8, T = 2048, TC = 256, MX = NB * T, MC = NB * TC, MT = MX + MC;
constexpr int D_IN = 2608, NP = 2560, NPG = 2816, NG = 48, DFF = 2816, DFE = 3584, NE = 8;
constexpr float EPS = 1e-6f;
constexpr int PC_GQ = 0, PC_GK = 128, PC_GV = 256, PC_GG = 512, PC_MQ = 768, PC_MK = 1024, PC_MV = 1280, PC_MO = 1536, PC_SU = 1792, PC_SV = 2048, PC_F = 2304;
constexpr int MOE_TILES = 136, MOE_PASS = 64;

constexpr size_t MiB = 1u << 20;
constexpr size_t WS_CTL = 0, CTL_ZERO_BYTES = 1 * MiB;
constexpr size_t WS_MOD = 1 * MiB;
constexpr size_t WS_ROUTE = 2 * MiB;
constexpr size_t WS_WSGU = 3 * MiB;
constexpr size_t WS_TWCH = 4 * MiB;
constexpr size_t WS_XC = 5 * MiB;
constexpr size_t WS_WTIN = 13 * MiB;
constexpr size_t WS_WTOUT = 24 * MiB;
constexpr size_t WS_WTGU = 28 * MiB;
constexpr size_t WS_WTD = 39 * MiB;
constexpr size_t WS_WTMGU = 45 * MiB;
constexpr size_t WS_WTMD = 157 * MiB;
constexpr size_t WS_R = 213 * MiB;
constexpr size_t WS_HM = WS_R + 0 * MiB;
constexpr size_t WS_P = WS_R + 36 * MiB;
constexpr size_t WS_G = WS_R + 126 * MiB;
constexpr size_t WS_QK = WS_R + 130 * MiB;
constexpr size_t WS_OG = WS_R + 148 * MiB;
constexpr size_t WS_OM = WS_R + 166 * MiB;
constexpr size_t WS_FBX = WS_R + 184 * MiB;
constexpr size_t WS_FBC = WS_R + 200 * MiB;
constexpr size_t WS_TWX = WS_R + 202 * MiB;
constexpr size_t WS_TWC = WS_R + 218 * MiB;
constexpr size_t WS_CPART = WS_R + 219 * MiB;
constexpr size_t WS_SCRG = WS_R + 219 * MiB;
constexpr size_t WS_SCRM = WS_R + 224 * MiB;
constexpr size_t WS_ACTF = WS_R + 36 * MiB;
constexpr size_t WS_XS = WS_R + 36 * MiB;
constexpr size_t WS_ACTM = WS_R + 104 * MiB;
constexpr size_t WS_YLP = WS_R + 0 * MiB;
constexpr size_t WS_MIXB = WS_R + 234 * MiB;
constexpr size_t WS_XS16 = WS_R + 244 * MiB;
constexpr size_t WS_END = WS_R + 276 * MiB;
constexpr int CW_BAR = 4096;
constexpr int CW_CNT = 16384;

constexpr int RING_BYTES = 131072, WAVE_LDS = 19968, LDSCTL_OFF = 8 * WAVE_LDS, MISC_OFF = LDSCTL_OFF + 320, LDS_BYTES = 163840;
static_assert(MISC_OFF + 128 <= LDS_BYTES && RING_BYTES <= LDSCTL_OFF, "LDS map");

#define GAS __attribute__((address_space(1)))
#define LAS __attribute__((address_space(3)))
typedef unsigned short bf16;
typedef unsigned v4u __attribute__((ext_vector_type(4)));
typedef unsigned v2u __attribute__((ext_vector_type(2)));
typedef float f32x4 __attribute__((ext_vector_type(4)));
typedef GAS unsigned gu32;
#define RLX_AGENT __ATOMIC_RELAXED, __HIP_MEMORY_SCOPE_AGENT
#define LDS_WAIT() asm volatile("s_waitcnt lgkmcnt(0)" ::: "memory")
__device__ __forceinline__ unsigned f2bf(float f) { unsigned u = __builtin_bit_cast(unsigned, f); return (u + 0x7fffu + ((u >> 16) & 1u)) >> 16; }
__device__ __forceinline__ unsigned pk2(float lo, float hi) { return f2bf(lo) | (f2bf(hi) << 16); }
__device__ __forceinline__ float bf2f(bf16 b) { return __builtin_bit_cast(float, ((unsigned)b) << 16); }
__device__ __forceinline__ float bflo(unsigned w) { return __builtin_bit_cast(float, w << 16); }
__device__ __forceinline__ float bfhi(unsigned w) { return __builtin_bit_cast(float, w & 0xffff0000u); }
__device__ __forceinline__ float sigmoidf_(float x) { return 1.f / (1.f + __expf(-x)); }
__device__ __forceinline__ float siluf_(float x) { return x / (1.f + __expf(-x)); }
__device__ __forceinline__ float logsigmoidf_(float x) { return fminf(x, 0.f) - log1pf(__expf(-fabsf(x))); }
__device__ __forceinline__ float wave_sum(float v) {
#define WS_DPP(x, ctrl, rmask, bc) __builtin_bit_cast(float, __builtin_amdgcn_update_dpp(0, __builtin_bit_cast(int, (x)), (ctrl), (rmask), 0xf, (bc)))
    v += WS_DPP(v, 0x111, 0xf, true); v += WS_DPP(v, 0x112, 0xf, true); v += WS_DPP(v, 0x114, 0xf, true); v += WS_DPP(v, 0x118, 0xf, true);
    v += WS_DPP(v, 0x142, 0xa, false); v += WS_DPP(v, 0x143, 0xc, false);
#undef WS_DPP
    return __builtin_bit_cast(float, __builtin_amdgcn_readlane(__builtin_bit_cast(int, v), 63));
}

#define XB_TMO      128
#define XB_XCNT(j)  (256  + 64 * (j))
#define XB_XSUB(j)  (1280 + 64 * (j))
#define XB_XGEN(j)  (2304 + 64 * (j))
#define XB_TOP      3328
#define XB_TOPGEN   3392
#define XCD_BAR_WORDS 3456
#define XB_SPIN_CAP (1u << 18)
__device__ __forceinline__ unsigned xb_ld(unsigned* p)              { return __hip_atomic_load(p, __ATOMIC_RELAXED, __HIP_MEMORY_SCOPE_AGENT); }
__device__ __forceinline__ unsigned xb_add(unsigned* p, unsigned v) { return __hip_atomic_fetch_add(p, v, __ATOMIC_RELAXED, __HIP_MEMORY_SCOPE_AGENT); }
__device__ __forceinline__ unsigned xb_xcc_id() { return (unsigned)__builtin_amdgcn_s_getreg((3 << 11) | 20) & 0xFu; }
#define XB_SPIN(cond, bar) do { unsigned _sp = 0; while (cond) { __builtin_amdgcn_s_sleep(1); \
    if ((++_sp & 255u) == 0u) { if (xb_ld(&(bar)[XB_TMO])) break; if (_sp > XB_SPIN_CAP) { atomicAdd(&(bar)[XB_TMO], 1u); break; } } } } while (0)
struct XcdBarrier { unsigned* bar; unsigned x; volatile LAS unsigned* st; };
__device__ __forceinline__ XcdBarrier xcd_barrier_post(unsigned* bar, volatile LAS unsigned* st) {
    XcdBarrier b; b.bar = bar; b.x = xb_xcc_id(); b.st = st;
    if (threadIdx.x == 0) (void)xb_add(&bar[XB_XCNT(b.x)], 1u);
    return b;
}
__device__ __forceinline__ void xcd_barrier_complete(unsigned* bar, unsigned x, unsigned& nloc, unsigned& nx) {
    const unsigned G = gridDim.x * gridDim.y * gridDim.z;
    unsigned sum, cnt, mine, sp = 0u;
    for (;;) {
        sum = 0u; cnt = 0u; mine = 0u;
#pragma unroll
        for (unsigned j = 0; j < 16; ++j) { const unsigned c = xb_ld(&bar[XB_XCNT(j)]); sum += c; cnt += (c > 0u) ? 1u : 0u; mine = (j == x) ? c : mine; }
        if (sum == G) break;
        __builtin_amdgcn_s_sleep(1);
        if ((++sp & 255u) == 0u) { if (xb_ld(&bar[XB_TMO])) break; if (sp > XB_SPIN_CAP) { atomicAdd(&bar[XB_TMO], 1u); break; } }
    }
    nloc = mine > 0u ? mine : 1u; nx = cnt > 0u ? cnt : 1u;
}
__device__ __forceinline__ void xcd_barrier(const XcdBarrier& b) {
    asm volatile("s_waitcnt vmcnt(0)" ::: "memory");
    __syncthreads();
    if (threadIdx.x == 0) {
        unsigned* bar = b.bar;
        __builtin_amdgcn_s_waitcnt(0);
        unsigned nloc = b.st[0], nx = b.st[1];
        if (nloc == 0u) { xcd_barrier_complete(bar, b.x, nloc, nx); b.st[0] = nloc; b.st[1] = nx; }
        const unsigned old = xb_add(&bar[XB_XSUB(b.x)], 1u);
        const unsigned gen = old / nloc;
        if (old + 1u == (gen + 1u) * nloc) {
            __builtin_amdgcn_fence(__ATOMIC_RELEASE, "agent");
            asm volatile("s_waitcnt vmcnt(0)" ::: "memory");
            const unsigned og = xb_add(&bar[XB_TOP], 1u);
            const unsigned tg = og / nx;
            if (og + 1u == (tg + 1u) * nx) xb_add(&bar[XB_TOPGEN], 1u);
            else XB_SPIN(xb_ld(&bar[XB_TOPGEN]) == tg, bar);
            __builtin_amdgcn_fence(__ATOMIC_ACQUIRE, "agent");
            xb_add(&bar[XB_XGEN(b.x)], 1u);
            asm volatile("s_waitcnt vmcnt(0)" ::: "memory");
        } else {
            XB_SPIN(xb_ld(&bar[XB_XGEN(b.x)]) == gen, bar);
            __builtin_amdgcn_fence(__ATOMIC_ACQUIRE, "agent");
            asm volatile("s_waitcnt vmcnt(0)" ::: "memory");
        }
    }
    __syncthreads();
}

struct DenseSched {
    const char* A; const char* Bt; size_t tstep; pg8::StaticOrder o;
    __device__ __forceinline__ void init(const void* A_, const void* Bt_, int nM, int nN, int K, int G, int c) { A = (const char*)A_; Bt = (const char*)Bt_; tstep = (size_t)256 * K * 2; o.init(nM, nN, G, c); }
    __device__ __forceinline__ bool next(int i, pg8::Unit& u) const { return o.next(i, u); }
    __device__ __forceinline__ const char* aptr(const pg8::Unit& u) const { return A + (size_t)u.pm * tstep; }
    __device__ __forceinline__ const char* bptr(const pg8::Unit& u) const { return Bt + (size_t)u.pn * tstep; }
};
struct InProjSched {
    const char* A; const char* Bt; size_t tstep; int nctx, G, c; pg8::StaticOrder o;
    __device__ __forceinline__ void init(const void* A_, const void* Bt_, int nctx_, int G_, int c_) { A = (const char*)A_; Bt = (const char*)Bt_; tstep = (size_t)256 * D * 2; nctx = nctx_; G = G_; c = c_; o.init(64, 11, G_, c_); }
    __device__ __forceinline__ bool next(int i, pg8::Unit& u) const {
        if (o.next(i, u)) return true;
        const int L = i * G + c - 64 * 11; if (L >= 8 * nctx) return false;
        u.pm = 64 + L / nctx; const int q = L % nctx; u.pn = (nctx == 11 || q < 7) ? q : 10; u.z = 0; return true; }
    __device__ __forceinline__ const char* aptr(const pg8::Unit& u) const { return A + (size_t)u.pm * tstep; }
    __device__ __forceinline__ const char* bptr(const pg8::Unit& u) const { return Bt + (size_t)u.pn * tstep; }
};
struct BatchSched {
    const char* A; const char* Bt; size_t tstep, zstride, hbytes; int nunits, npm, G, c;
    __device__ __forceinline__ bool next(int i, pg8::Unit& u) const { const int L = i * G + c; if (L < 0 || L >= nunits) return false; u.z = L / (2 * npm); const int rem = L % (2 * npm); u.pm = rem >> 1; u.pn = rem & 1; return true; }
    __device__ __forceinline__ const char* aptr(const pg8::Unit& u) const { return A + (size_t)u.pm * tstep + (size_t)u.pn * hbytes; }
    __device__ __forceinline__ const char* bptr(const pg8::Unit& u) const { return Bt + (size_t)u.z * zstride + (size_t)u.pn * hbytes; }
};
struct EpiFourier {
    static constexpr bool PERM = true;
    bf16* O0; int ld0; size_t zs0; bf16* O1; int ld1; size_t zs1;
    __device__ __forceinline__ void operator()(const pg8::f32x4 (&acc)[2][2][4][2], const pg8::Unit& u, int wr, int wc, int fr, int fq) const {
        const int row0 = u.pm * 256 + wr * 64 + fr, col0 = wc * 32 + 8 * fq; const int ldc = u.pn ? ld1 : ld0; bf16* base = u.pn ? O1 + (size_t)u.z * zs1 : O0 + (size_t)u.z * zs0;
#pragma unroll
        for (int ai = 0; ai < 2; ++ai)
#pragma unroll
            for (int m = 0; m < 4; ++m) { bf16* rowp = base + (size_t)(row0 + ai * 128 + m * 16) * ldc + col0;
#pragma unroll
                for (int bj = 0; bj < 2; ++bj) { const pg8::f32x4 v0 = acc[ai][bj][m][0], v1 = acc[ai][bj][m][1];
                    pg8::u32x4 w; w.x = pg8::cvt_pk_bf16(v0[0], v0[1]); w.y = pg8::cvt_pk_bf16(v0[2], v0[3]); w.z = pg8::cvt_pk_bf16(v1[0], v1[1]); w.w = pg8::cvt_pk_bf16(v1[2], v1[3]);
                    *(pg8::u32x4*)(rowp + bj * 128) = w; } }
    }
};
struct MoeSched {
    const char* A; const char* W; size_t tstepA, tstepW, estride; int tb[9]; int t0; pg8::StaticOrder o;
    __device__ __forceinline__ bool next(int i, pg8::Unit& u) const {
        if (!o.next(i, u)) return false; const int gt = t0 + u.pm; int e = 0;
#pragma unroll
        for (int j = 1; j < 8; ++j) e += (gt >= tb[j]) ? 1 : 0;
        u.z = e; return true; }
    __device__ __forceinline__ const char* aptr(const pg8::Unit& u) const { return A + (size_t)u.pm * tstepA; }
    __device__ __forceinline__ const char* bptr(const pg8::Unit& u) const { return W + (size_t)u.z * estride + (size_t)u.pn * tstepW; }
};

struct CtxSplitSched {
    const char* A; const char* Bt; size_t tstep, kbytes; int G, c;
    __device__ __forceinline__ bool next(int i, pg8::Unit& u) const { const int L = i * G + c; if (L >= 64) return false; u.pm = L >> 3; u.pn = ((L >> 1) & 3) | ((L & 1) << 2); u.z = 0; return true; }
    __device__ __forceinline__ const char* aptr(const pg8::Unit& u) const { return A + (size_t)u.pm * tstep + (size_t)(u.pn >> 2) * kbytes; }
    __device__ __forceinline__ const char* bptr(const pg8::Unit& u) const { return Bt + (size_t)(u.pn & 3) * tstep + (size_t)(u.pn >> 2) * kbytes; }
};
struct KSplitSched {
    const char* A; const char* W; size_t tstepA, tstepW, estride; int tb[9]; int nunits, G, c;
    __device__ __forceinline__ bool next(int i, pg8::Unit& u) const {
        const int L = i * G + c; if (L >= nunits) return false; u.pm = L >> 4; u.pn = L & 15; const int gt = 128 + u.pm; int e = 0;
#pragma unroll
        for (int j = 1; j < 8; ++j) e += (gt >= tb[j]) ? 1 : 0;
        u.z = e; return true; }
    __device__ __forceinline__ const char* aptr(const pg8::Unit& u) const { return A + (size_t)u.pm * tstepA + (size_t)(u.pn >> 2) * (896 * 2); }
    __device__ __forceinline__ const char* bptr(const pg8::Unit& u) const { return W + (size_t)u.z * estride + (size_t)(u.pn & 3) * tstepW + (size_t)(u.pn >> 2) * (896 * 2); }
};
struct EpiKSplit {
    static constexpr bool PERM = true;
    bf16* O; size_t kstride;
    __device__ __forceinline__ void operator()(const pg8::f32x4 (&acc)[2][2][4][2], const pg8::Unit& u, int wr, int wc, int fr, int fq) const {
        const int row0 = u.pm * 256 + wr * 64 + fr, col0 = (u.pn & 3) * 256 + wc * 32 + 8 * fq; bf16* base = O + (size_t)(u.pn >> 2) * kstride;
#pragma unroll
        for (int ai = 0; ai < 2; ++ai)
#pragma unroll
            for (int m = 0; m < 4; ++m) { bf16* rowp = base + (size_t)(row0 + ai * 128 + m * 16) * D + col0;
#pragma unroll
                for (int bj = 0; bj < 2; ++bj) { const pg8::f32x4 v0 = acc[ai][bj][m][0], v1 = acc[ai][bj][m][1];
                    pg8::u32x4 w; w.x = pg8::cvt_pk_bf16(v0[0], v0[1]); w.y = pg8::cvt_pk_bf16(v0[2], v0[3]); w.z = pg8::cvt_pk_bf16(v1[0], v1[1]); w.w = pg8::cvt_pk_bf16(v1[2], v1[3]);
                    *(pg8::u32x4*)(rowp + bj * 128) = w; } }
    }
};
struct EpiBf16Plain {
    static constexpr bool PERM = true;
    bf16* O; int ldc; size_t zstride;
    __device__ __forceinline__ void operator()(const pg8::f32x4 (&acc)[2][2][4][2], const pg8::Unit& u, int wr, int wc, int fr, int fq) const {
        const int row0 = u.pm * 256 + wr * 64 + fr, col0 = u.pn * 256 + wc * 32 + 8 * fq; bf16* base = O + (size_t)u.z * zstride;
#pragma unroll
        for (int ai = 0; ai < 2; ++ai)
#pragma unroll
            for (int m = 0; m < 4; ++m) { bf16* rowp = base + (size_t)(row0 + ai * 128 + m * 16) * ldc + col0;
#pragma unroll
                for (int bj = 0; bj < 2; ++bj) { const pg8::f32x4 v0 = acc[ai][bj][m][0], v1 = acc[ai][bj][m][1];
                    pg8::u32x4 w; w.x = pg8::cvt_pk_bf16(v0[0], v0[1]); w.y = pg8::cvt_pk_bf16(v0[2], v0[3]); w.z = pg8::cvt_pk_bf16(v1[0], v1[1]); w.w = pg8::cvt_pk_bf16(v1[2], v1[3]);
                    *(pg8::u32x4*)(rowp + bj * 128) = w; } }
    }
};
struct EpiInProj {
    static constexpr bool PERM = true;
    bf16* O; float* GT;
    __device__ __forceinline__ void operator()(const pg8::f32x4 (&acc)[2][2][4][2], const pg8::Unit& u, int wr, int wc, int fr, int fq) const {
        const int row0 = u.pm * 256 + wr * 64 + fr;
        if (u.pn < NP / 256) {
            const int col0 = u.pn * 256 + wc * 32 + 8 * fq;
#pragma unroll
            for (int ai = 0; ai < 2; ++ai)
#pragma unroll
                for (int m = 0; m < 4; ++m) { bf16* rowp = O + (size_t)(row0 + ai * 128 + m * 16) * NP + col0;
#pragma unroll
                    for (int bj = 0; bj < 2; ++bj) { const pg8::f32x4 v0 = acc[ai][bj][m][0], v1 = acc[ai][bj][m][1];
                        pg8::u32x4 w; w.x = pg8::cvt_pk_bf16(v0[0], v0[1]); w.y = pg8::cvt_pk_bf16(v0[2], v0[3]); w.z = pg8::cvt_pk_bf16(v1[0], v1[1]); w.w = pg8::cvt_pk_bf16(v1[2], v1[3]);
                        *(pg8::u32x4*)(rowp + bj * 128) = w; } }
        } else {
            const int col0 = wc * 32 + 8 * fq;
            if (col0 < NG) {
#pragma unroll
                for (int ai = 0; ai < 2; ++ai)
#pragma unroll
                    for (int m = 0; m < 4; ++m) { float* rowp = GT + (size_t)(row0 + ai * 128 + m * 16) * NG + col0;
                        *(pg8::f32x4*)rowp = acc[ai][0][m][0]; *(pg8::f32x4*)(rowp + 4) = acc[ai][0][m][1]; } }
        }
    }
};
struct EpiSwiGLU {
    static constexpr bool PERM = true;
    bf16* O; int ldc;
    __device__ __forceinline__ void operator()(const pg8::f32x4 (&acc)[2][2][4][2], const pg8::Unit& u, int wr, int wc, int fr, int fq) const {
        const int row0 = u.pm * 256 + wr * 64 + fr, col0 = u.pn * 128 + wc * 32 + 8 * fq;
#pragma unroll
        for (int ai = 0; ai < 2; ++ai)
#pragma unroll
            for (int m = 0; m < 4; ++m) { bf16* rowp = O + (size_t)(row0 + ai * 128 + m * 16) * ldc + col0;
                float r[8];
#pragma unroll
                for (int n = 0; n < 2; ++n)
#pragma unroll
                    for (int j = 0; j < 4; ++j) { const float g = acc[ai][0][m][n][j], uu = acc[ai][1][m][n][j]; r[n * 4 + j] = g * uu * __builtin_amdgcn_rcpf(1.f + __expf(-g)); }
                pg8::u32x4 w; w.x = pg8::cvt_pk_bf16(r[0], r[1]); w.y = pg8::cvt_pk_bf16(r[2], r[3]); w.z = pg8::cvt_pk_bf16(r[4], r[5]); w.w = pg8::cvt_pk_bf16(r[6], r[7]);
                *(pg8::u32x4*)rowp = w; }
    }
};
struct EpiResGate {
    static constexpr bool PERM = false;
    const float* xbase; float* xout; const float* cbase; float* cout; const float* modl; int goff;
    __device__ __forceinline__ void operator()(const pg8::f32x4 (&acc)[2][2][4][2], const pg8::Unit& u, int wr, int wc, int fr, int fq) const {
        const float* basep; float* outp; int bidx;
        if (u.pm < 64) { bidx = u.pm >> 3; basep = xbase + (size_t)u.pm * 256 * D; outp = xout + (size_t)u.pm * 256 * D; }
        else { bidx = 8; basep = cbase + (size_t)(u.pm - 64) * 256 * D; outp = cout + (size_t)(u.pm - 64) * 256 * D; }
        const float* gatep = modl + bidx * 6144 + goff;
        const int col0 = u.pn * 256 + wc * 32 + 4 * fq, r0 = wr * 64 + fr;
        pg8::f32x4 gv[2][2];
#pragma unroll
        for (int bj = 0; bj < 2; ++bj)
#pragma unroll
            for (int n = 0; n < 2; ++n) gv[bj][n] = *(const pg8::f32x4*)(gatep + col0 + bj * 128 + n * 16);
#pragma unroll
        for (int ai = 0; ai < 2; ++ai)
#pragma unroll
            for (int m = 0; m < 4; ++m) { const size_t off = (size_t)(r0 + ai * 128 + m * 16) * D + col0;
#pragma unroll
                for (int bj = 0; bj < 2; ++bj)
#pragma unroll
                    for (int n = 0; n < 2; ++n) { const pg8::f32x4 bs = *(const pg8::f32x4*)(basep + off + bj * 128 + n * 16);
                        *(pg8::f32x4*)(outp + off + bj * 128 + n * 16) = bs + gv[bj][n] * acc[ai][bj][m][n]; } }
    }
};


typedef short s16x4 __attribute__((ext_vector_type(4)));
typedef short bf16x8v __attribute__((ext_vector_type(8)));
template <int CTRL> __device__ __forceinline__ float dpp_f0(float x) { return __builtin_bit_cast(float, __builtin_amdgcn_update_dpp(0, __builtin_bit_cast(int, x), CTRL, 0xf, 0xf, true)); }
template <int CTRL> __device__ __forceinline__ float dpp_fninf(float x) { return __builtin_bit_cast(float, __builtin_amdgcn_update_dpp((int)0xff800000u, __builtin_bit_cast(int, x), CTRL, 0xf, 0xf, false)); }
template <int CTRL> __device__ __forceinline__ float dpp_any(float x) { return __builtin_bit_cast(float, __builtin_amdgcn_update_dpp(0, __builtin_bit_cast(int, x), CTRL, 0xf, 0xf, false)); }
__device__ __forceinline__ float row_bcast15(float x) { return dpp_any<0x15F>(x); }
__device__ __forceinline__ float row_sum16(float x) { x += dpp_any<0x121>(x); x += dpp_any<0x122>(x); x += dpp_any<0x124>(x); x += dpp_any<0x128>(x); return x; }
__device__ __forceinline__ float quad_sum4(float x) { x += dpp_any<0xB1>(x); x += dpp_any<0x4E>(x); return x; }
__device__ __forceinline__ float lane_bcast(float x, int l) { return __builtin_bit_cast(float, __builtin_amdgcn_readlane(__builtin_bit_cast(int, x), l)); }
__device__ __forceinline__ float row_scan_add(float x) { x += dpp_f0<0x111>(x); x += dpp_f0<0x112>(x); x += dpp_f0<0x114>(x); x += dpp_f0<0x118>(x); return x; }
__device__ __forceinline__ float row_scan_max(float x) { x = fmaxf(x, dpp_fninf<0x111>(x)); x = fmaxf(x, dpp_fninf<0x112>(x)); x = fmaxf(x, dpp_fninf<0x114>(x)); x = fmaxf(x, dpp_fninf<0x118>(x)); return x; }
__device__ __forceinline__ bf16x8v pack8(const float (&v)[8]) { v4u w; w.x = pg8::cvt_pk_safe(v[0], v[1]); w.y = pg8::cvt_pk_safe(v[2], v[3]); w.z = pg8::cvt_pk_safe(v[4], v[5]); w.w = pg8::cvt_pk_safe(v[6], v[7]); return __builtin_bit_cast(bf16x8v, w); }
__device__ __forceinline__ bf16x8v cat4(s16x4 lo, s16x4 hi) { return __builtin_shufflevector(lo, hi, 0, 1, 2, 3, 4, 5, 6, 7); }
__device__ __forceinline__ s16x4 tr_read(LAS unsigned char* p) { return __builtin_amdgcn_ds_read_tr16_b64_v4i16((LAS s16x4*)p); }
#define MFMA16(a, b, c) __builtin_amdgcn_mfma_f32_16x16x32_bf16((a), (b), (c), 0, 0, 0)

constexpr int GL_V = 0, GL_K2 = 9216, GL_SC = 14336, GL_MISC = 16640;
constexpr int SCRG_SEQ = 81920;
#define WG_SYNC_GLOBAL() do { asm volatile("s_waitcnt vmcnt(0)" ::: "memory"); __syncthreads(); __builtin_amdgcn_fence(__ATOMIC_ACQUIRE, "agent"); } while (0)
template <int l>
__device__ __forceinline__ void gla_scan(LAS unsigned char* lds, unsigned char* ws, const float* w_lr, const float* b_lr, const int seq, const int wave, const int lane_in, const bool ctx_out) {
    const int b = seq >> 3, h = (seq >> 1) & 3, dir = seq & 1;
    LAS unsigned char* W = lds + wave * WAVE_LDS;
    const bf16* P = (const bf16*)(ws + WS_P); const float* GT = (const float*)(ws + WS_G); bf16* OG = (bf16*)(ws + WS_OG);
    const int r = lane_in & 15, g = lane_in >> 4;
    bf16x8v wfrag[2]; float bias[2][4];
#pragma unroll
    for (int dt = 0; dt < 2; ++dt) { float t[8];
#pragma unroll
        for (int j = 0; j < 8; ++j) t[j] = g < 2 ? w_lr[((size_t)(l * 2 + dir) * 16 + 8 * g + j) * 128 + h * 32 + 16 * dt + r] : 0.f;
        wfrag[dt] = pack8(t);
#pragma unroll
        for (int rg = 0; rg < 4; ++rg) bias[dt][rg] = b_lr[(l * 2 + dir) * 128 + h * 32 + 16 * dt + 4 * g + rg]; }
    const pg8::f32x4 zero4 = {0.f, 0.f, 0.f, 0.f};
    pg8::f32x4 Sown = zero4;
    for (int round = 0; round < 5; ++round) {
        int lane = lane_in; asm volatile("" : "+v"(lane));
        const int r = lane & 15, g = lane >> 4, q4 = r >> 2, p4 = lane & 3;
        const int n = round * 8 + wave; const bool active = n < 36;
        int rowbase = 0;
        if (n < 4) rowbase = MX + b * TC + (dir ? 3 - n : n) * 64; else rowbase = b * T + (dir ? 35 - n : n - 4) * 64;
        const int rsgn = dir ? -1 : 1, roff = dir ? rowbase + 63 : rowbase;
        bf16x8v Qf[4], Vf[4][2], K2f[2][2]; pg8::f32x4 O[4][4];
        if (active) {
#pragma unroll
            for (int it = 0; it < 8; ++it) { const int sp = it * 8 + (lane >> 3);
                const v4u x = *(const v4u*)(P + (size_t)(roff + rsgn * sp) * NP + PC_GV + h * 64 + (lane & 7) * 8);
                *(LAS v4u*)(W + GL_V + sp * 144 + (lane & 7) * 16) = x; }
            v2u qp[4][2], kp[4][2]; float la[4][8];
#pragma unroll
            for (int i = 0; i < 4; ++i) { const size_t tok = (size_t)(roff + rsgn * (16 * i + r));
                qp[i][0] = *(const v2u*)(P + tok * NP + PC_GQ + h * 32 + 4 * g); qp[i][1] = *(const v2u*)(P + tok * NP + PC_GQ + h * 32 + 16 + 4 * g);
                kp[i][0] = *(const v2u*)(P + tok * NP + PC_GK + h * 32 + 4 * g); kp[i][1] = *(const v2u*)(P + tok * NP + PC_GK + h * 32 + 16 + 4 * g);
                float lr[8];
                if (g < 2) { const f32x4 a0 = *(const f32x4*)(GT + tok * NG + dir * 16 + 8 * g), a1 = *(const f32x4*)(GT + tok * NG + dir * 16 + 8 * g + 4);
                    lr[0] = a0.x; lr[1] = a0.y; lr[2] = a0.z; lr[3] = a0.w; lr[4] = a1.x; lr[5] = a1.y; lr[6] = a1.z; lr[7] = a1.w; }
                else {
#pragma unroll
                    for (int j = 0; j < 8; ++j) lr[j] = 0.f; }
                const bf16x8v lrf = pack8(lr);
#pragma unroll
                for (int dt = 0; dt < 2; ++dt) { const pg8::f32x4 z = MFMA16(wfrag[dt], lrf, zero4);
#pragma unroll
                    for (int rg = 0; rg < 4; ++rg) { const float zz = z[rg] + bias[dt][rg]; la[i][dt * 4 + rg] = (fminf(zz, 0.f) - __logf(1.f + __expf(-fabsf(zz)))) * (1.f / 16.f); } } }
            float cl[8];
#pragma unroll
            for (int j = 0; j < 8; ++j) { float carry = 0.f;
#pragma unroll
                for (int i = 0; i < 4; ++i) { const float x = row_scan_add(la[i][j]) + carry; la[i][j] = x; carry = row_bcast15(x); }
                cl[j] = carry; }
            bf16x8v Kf[4]; float ecl[8];
#pragma unroll
            for (int j = 0; j < 8; ++j) ecl[j] = __expf(cl[j]);
#pragma unroll
            for (int i = 0; i < 4; ++i) { float tq[8], tk[8], t2[8];
                const float qv[8] = {bflo(qp[i][0].x), bfhi(qp[i][0].x), bflo(qp[i][0].y), bfhi(qp[i][0].y), bflo(qp[i][1].x), bfhi(qp[i][1].x), bflo(qp[i][1].y), bfhi(qp[i][1].y)};
                const float kv[8] = {bflo(kp[i][0].x), bfhi(kp[i][0].x), bflo(kp[i][0].y), bfhi(kp[i][0].y), bflo(kp[i][1].x), bfhi(kp[i][1].x), bflo(kp[i][1].y), bfhi(kp[i][1].y)};
#pragma unroll
                for (int j = 0; j < 8; ++j) { const float e1 = __expf(la[i][j]), kinv = kv[j] * __builtin_amdgcn_rcpf(e1); tq[j] = qv[j] * 0.17677669529663687f * e1; tk[j] = kinv; t2[j] = kinv * ecl[j]; }
                Qf[i] = pack8(tq); Kf[i] = pack8(tk);
                *(LAS bf16x8v*)(W + GL_K2 + (16 * i + r) * 80 + 16 * g) = pack8(t2); }
            if (r == 0) {
#pragma unroll
                for (int j = 0; j < 8; ++j) ((LAS float*)(W + GL_MISC))[8 * g + j] = ecl[j]; }
#pragma unroll
            for (int dt = 0; dt < 4; ++dt)
#pragma unroll
                for (int ks = 0; ks < 2; ++ks) { LAS unsigned char* a = W + GL_V + (32 * ks + 8 * g + q4) * 144 + (16 * dt + 4 * p4) * 2; Vf[dt][ks] = cat4(tr_read(a), tr_read(a + 4 * 144)); }
#pragma unroll
            for (int dd = 0; dd < 2; ++dd)
#pragma unroll
                for (int ks = 0; ks < 2; ++ks) { LAS unsigned char* a = W + GL_K2 + (32 * ks + 8 * g + q4) * 80 + (16 * dd + 4 * p4) * 2; K2f[dd][ks] = cat4(tr_read(a), tr_read(a + 4 * 80)); }
#pragma unroll
            for (int li = 0; li < 4; ++li) {
#pragma unroll
                for (int si = 0; si < 4; ++si) { pg8::f32x4 dd4 = zero4;
                    if (si <= li) { dd4 = MFMA16(Kf[si], Qf[li], zero4);
                        if (si == li) {
#pragma unroll
                            for (int rg = 0; rg < 4; ++rg) dd4[rg] = (r >= 4 * g + rg) ? dd4[rg] : 0.f; } }
                    v2u w; w.x = pg8::cvt_pk_safe(dd4[0], dd4[1]); w.y = pg8::cvt_pk_safe(dd4[2], dd4[3]);
                    *(LAS v2u*)(W + GL_SC + r * 144 + (16 * si + 4 * g) * 2) = w; }
#pragma unroll
                for (int ks = 0; ks < 2; ++ks) { const bf16x8v scf = *(const LAS bf16x8v*)(W + GL_SC + r * 144 + (32 * ks + 8 * g) * 2);
#pragma unroll
                    for (int dt = 0; dt < 4; ++dt) O[dt][li] = MFMA16(Vf[dt][ks], scf, ks == 0 ? zero4 : O[dt][li]); }
            }
        }
        __syncthreads();
        if (active) {
#pragma unroll
            for (int dd = 0; dd < 2; ++dd)
#pragma unroll
                for (int dt = 0; dt < 4; ++dt) { pg8::f32x4 U = MFMA16(K2f[dd][0], Vf[dt][0], zero4); U = MFMA16(K2f[dd][1], Vf[dt][1], U);
                    *(LAS pg8::f32x4*)(lds + (dd * 4 + dt) * WAVE_LDS + GL_V + wave * 1024 + lane * 16) = U; }
        }
        __syncthreads();
        {
            const int odd = wave >> 2, odt = wave & 3;
            pg8::f32x4 Uj[8], Dj[8];
#pragma unroll
            for (int j = 0; j < 8; ++j) { Uj[j] = *(const LAS pg8::f32x4*)(W + GL_V + j * 1024 + lane * 16); Dj[j] = *(const LAS pg8::f32x4*)(lds + j * WAVE_LDS + GL_MISC + (16 * odd + 4 * g) * 4); }
#pragma unroll
            for (int j = 0; j < 8; ++j) if (round * 8 + j < 36) {
                v2u w; w.x = pg8::cvt_pk_safe(Sown[0], Sown[1]); w.y = pg8::cvt_pk_safe(Sown[2], Sown[3]);
                *(LAS v2u*)(lds + j * WAVE_LDS + GL_K2 + (16 * odt + r) * 80 + (16 * odd + 4 * g) * 2) = w;
                Sown = Dj[j] * Sown + Uj[j]; }
        }
        __syncthreads();
        if (active) {
#pragma unroll
            for (int dt = 0; dt < 4; ++dt) { const bf16x8v stf = *(const LAS bf16x8v*)(W + GL_K2 + (16 * dt + r) * 80 + 16 * g);
#pragma unroll
                for (int li = 0; li < 4; ++li) O[dt][li] = MFMA16(stf, Qf[li], O[dt][li]); }
            if (n >= 4 || ctx_out) {
#pragma unroll
                for (int li = 0; li < 4; ++li) { bf16* orow = OG + ((size_t)dir * MT + (size_t)(roff + rsgn * (16 * li + r))) * 256 + h * 64 + 4 * g;
#pragma unroll
                    for (int dt = 0; dt < 4; ++dt) { v2u w; w.x = pg8::cvt_pk_safe(O[dt][li][0], O[dt][li][1]); w.y = pg8::cvt_pk_safe(O[dt][li][2], O[dt][li][3]); *(v2u*)(orow + 16 * dt) = w; } } }
        }
    }
}


constexpr int ML_V = 0, ML_KW = 8192, ML_SC = 16384, ML_B = 18688, ML_PM = 18944, ML_CUM = 19200, ML_DMX = 19456, ML_N = 19712;
constexpr int SCRM_SLOT = 4224, SCRM_SEQ = 9 * SCRM_SLOT * 4;
template <int l>
__device__ __forceinline__ void mlstm_scan(LAS unsigned char* lds, unsigned char* ws, const float* gate_b, const int seq, const int wave, const int lane_in, const bool ctx_out) {
    const int b = seq >> 3, h = (seq >> 1) & 3, dir = seq & 1;
    LAS unsigned char* W = lds + wave * WAVE_LDS;
    const bf16* P = (const bf16*)(ws + WS_P); const bf16* QK = (const bf16*)(ws + WS_QK); const float* GT = (const float*)(ws + WS_G); bf16* OM = (bf16*)(ws + WS_OM);
    const float gbi = gate_b[((l * 2 + dir) * 2 + 0) * 4 + h], gbf = gate_b[((l * 2 + dir) * 2 + 1) * 4 + h];
    const pg8::f32x4 zero4 = {0.f, 0.f, 0.f, 0.f};
    const bf16x8v ones = {16256, 16256, 16256, 16256, 16256, 16256, 16256, 16256};
    pg8::f32x4 Cown[2] = {zero4, zero4}, nown = zero4; float mst = 0.f;
    for (int round = 0; round < 5; ++round) {
        int lane = lane_in; asm volatile("" : "+v"(lane));
        const int r = lane & 15, g = lane >> 4, q4 = r >> 2, p4 = lane & 3;
        const int n = round * 8 + wave; const bool active = n < 36;
        int rowbase = 0;
        if (n < 4) rowbase = MX + b * TC + (dir ? 3 - n : n) * 64; else rowbase = b * T + (dir ? 35 - n : n - 4) * 64;
        const int rsgn = dir ? -1 : 1, roff = dir ? rowbase + 63 : rowbase;
        bf16x8v qf[4][2], Vf[4][2], kwf[4][2]; pg8::f32x4 O[4][4]; float dl[4] = {0.f, 0.f, 0.f, 0.f}; float fl_own = 0.f, mc_own = 0.f;
        if (active) {
#pragma unroll
            for (int it = 0; it < 8; ++it) { const int sp = it * 8 + (lane >> 3);
                const v4u x = *(const v4u*)(P + (size_t)(roff + rsgn * sp) * NP + PC_MV + h * 64 + (lane & 7) * 8);
                *(LAS v4u*)(W + ML_V + sp * 128 + (lane & 7) * 16) = x; }
            float wk;
            { const size_t rt = (size_t)(roff + rsgn * lane);
              const float ip = GT[rt * NG + 32 + dir * 8 + h] + gbi, fp = GT[rt * NG + 32 + dir * 8 + 4 + h] + gbf;
              const float lf = fminf(fp, 0.f) - __logf(1.f + __expf(-fabsf(fp)));
              float x = row_scan_add(lf); const float t0 = lane_bcast(x, 15), t1 = lane_bcast(x, 31), t2 = lane_bcast(x, 47);
              const float cum = x + (g >= 1 ? t0 : 0.f) + (g >= 2 ? t1 : 0.f) + (g >= 3 ? t2 : 0.f);
              const float cl = lane_bcast(cum, 63);
              const float bb = ip - cum;
              float y = row_scan_max(bb); const float m0 = lane_bcast(y, 15), m1 = lane_bcast(y, 31), m2 = lane_bcast(y, 47);
              float cm = -3.0e38f; if (g >= 1) cm = m0; if (g >= 2) cm = fmaxf(cm, m1); if (g >= 3) cm = fmaxf(cm, m2);
              const float pm = fmaxf(y, cm), pm63 = lane_bcast(pm, 63);
              mc_own = cl + pm63; fl_own = cl; wk = __expf(bb - pm63) * 0.125f;
              ((LAS float*)(W + ML_B))[lane] = bb; ((LAS float*)(W + ML_PM))[lane] = pm; ((LAS float*)(W + ML_CUM))[lane] = cum; ((LAS float*)(W + ML_DMX))[lane] = cum + pm; }
            bf16x8v kf[4][2];
#pragma unroll
            for (int i = 0; i < 4; ++i) { const size_t tok = (size_t)(roff + rsgn * (16 * i + r)); const float wki = __shfl(wk, 16 * i + r);
#pragma unroll
                for (int ks = 0; ks < 2; ++ks) { qf[i][ks] = *(const bf16x8v*)(QK + tok * 512 + h * 64 + 32 * ks + 8 * g); kf[i][ks] = *(const bf16x8v*)(QK + tok * 512 + 256 + h * 64 + 32 * ks + 8 * g);
                    const v4u kw4 = __builtin_bit_cast(v4u, kf[i][ks]);
                    float t[8] = {bflo(kw4.x) * wki, bfhi(kw4.x) * wki, bflo(kw4.y) * wki, bfhi(kw4.y) * wki, bflo(kw4.z) * wki, bfhi(kw4.z) * wki, bflo(kw4.w) * wki, bfhi(kw4.w) * wki};
                    *(LAS bf16x8v*)(W + ML_KW + (16 * i + r) * 128 + (32 * ks + 8 * g) * 2) = pack8(t); } }
#pragma unroll
            for (int dt = 0; dt < 4; ++dt)
#pragma unroll
                for (int ks = 0; ks < 2; ++ks) { LAS unsigned char* a = W + ML_V + (32 * ks + 8 * g + q4) * 128 + (16 * dt + 4 * p4) * 2; Vf[dt][ks] = cat4(tr_read(a), tr_read(a + 4 * 128)); }
#pragma unroll
            for (int li = 0; li < 4; ++li) { const float pml = ((const LAS float*)(W + ML_PM))[16 * li + r];
#pragma unroll
                for (int si = 0; si < 4; ++si) { pg8::f32x4 x4 = zero4;
                    if (si <= li) { x4 = MFMA16(kf[si][0], qf[li][0], zero4); x4 = MFMA16(kf[si][1], qf[li][1], x4);
                        const pg8::f32x4 bs = *(const LAS pg8::f32x4*)(W + ML_B + (16 * si + 4 * g) * 4);
#pragma unroll
                        for (int rg = 0; rg < 4; ++rg) { const float v = __expf(bs[rg] - pml) * x4[rg] * 0.125f; x4[rg] = (si < li || r >= 4 * g + rg) ? v : 0.f; } }
                    v2u w; w.x = pg8::cvt_pk_safe(x4[0], x4[1]); w.y = pg8::cvt_pk_safe(x4[2], x4[3]);
                    *(LAS v2u*)(W + ML_SC + r * 144 + (16 * si + 4 * g) * 2) = w; }
                pg8::f32x4 DLt = zero4;
#pragma unroll
                for (int ks = 0; ks < 2; ++ks) { const bf16x8v scf = *(const LAS bf16x8v*)(W + ML_SC + r * 144 + (32 * ks + 8 * g) * 2);
#pragma unroll
                    for (int dt = 0; dt < 4; ++dt) O[dt][li] = MFMA16(Vf[dt][ks], scf, ks == 0 ? zero4 : O[dt][li]);
                    DLt = MFMA16(ones, scf, DLt); }
                dl[li] = DLt[0];
            }
#pragma unroll
            for (int dd = 0; dd < 4; ++dd)
#pragma unroll
                for (int ks = 0; ks < 2; ++ks) { LAS unsigned char* a = W + ML_KW + (32 * ks + 8 * g + q4) * 128 + (16 * dd + 4 * p4) * 2; kwf[dd][ks] = cat4(tr_read(a), tr_read(a + 4 * 128)); }
        }
        __syncthreads();
        if (active) {
#pragma unroll
            for (int dd = 0; dd < 4; ++dd) { pg8::f32x4 Un = MFMA16(kwf[dd][0], ones, zero4); Un = MFMA16(kwf[dd][1], ones, Un);
#pragma unroll
                for (int dt = 0; dt < 4; ++dt) { pg8::f32x4 U = MFMA16(kwf[dd][0], Vf[dt][0], zero4); U = MFMA16(kwf[dd][1], Vf[dt][1], U);
                    v2u w; w.x = pg8::cvt_pk_safe(U[0], U[1]); w.y = pg8::cvt_pk_safe(U[2], U[3]);
                    *(LAS v2u*)(lds + (2 * dd + (dt >> 1)) * WAVE_LDS + ML_V + ((dt & 1) * 8 + wave) * 512 + lane * 8) = w; }
                if (r == 0) *(LAS pg8::f32x4*)(W + ML_B + (16 * dd + 4 * g) * 4) = Un; }
            if (lane == 0) { ((LAS float*)(W + ML_PM))[0] = mc_own; ((LAS float*)(W + ML_PM))[1] = fl_own; }
        }
        __syncthreads();
        float m = 0.f;
        {
            const int odd = wave >> 1, odt = 2 * (wave & 1);
#pragma unroll
            for (int j = 0; j < 8; ++j) if (round * 8 + j < 36) {
                LAS unsigned char* Wj = lds + j * WAVE_LDS;
                const float mcj = ((const LAS float*)(Wj + ML_PM))[0], flj = ((const LAS float*)(Wj + ML_PM))[1];
                const v2u u0 = *(const LAS v2u*)(W + ML_V + j * 512 + lane * 8), u1 = *(const LAS v2u*)(W + ML_V + (8 + j) * 512 + lane * 8);
                const pg8::f32x4 Nj = wave < 4 ? *(const LAS pg8::f32x4*)(Wj + ML_B + (16 * wave + 4 * g) * 4) : zero4;
#pragma unroll
                for (int t = 0; t < 2; ++t) { v2u w; w.x = pg8::cvt_pk_safe(Cown[t][0], Cown[t][1]); w.y = pg8::cvt_pk_safe(Cown[t][2], Cown[t][3]);
                    *(LAS v2u*)(Wj + ML_KW + (16 * (odt + t) + r) * 128 + (16 * odd + 4 * g) * 2) = w; }
                if (wave < 4 && r == 0) { v2u w; w.x = pg8::cvt_pk_safe(nown[0], nown[1]); w.y = pg8::cvt_pk_safe(nown[2], nown[3]); *(LAS v2u*)(Wj + ML_N + (16 * wave + 4 * g) * 2) = w; }
                if (j == wave) m = mst;
                const float mn = fmaxf(flj + mst, mcj), a = __expf(flj + mst - mn), gs = __expf(mcj - mn);
                Cown[0] = Cown[0] * a + (pg8::f32x4){bflo(u0.x), bfhi(u0.x), bflo(u0.y), bfhi(u0.y)} * gs; Cown[1] = Cown[1] * a + (pg8::f32x4){bflo(u1.x), bfhi(u1.x), bflo(u1.y), bfhi(u1.y)} * gs; nown = nown * a + Nj * gs; mst = mn; }
        }
        __syncthreads();
        if (active) {
            bf16x8v nf[2];
#pragma unroll
            for (int ks = 0; ks < 2; ++ks) nf[ks] = *(const LAS bf16x8v*)(W + ML_N + (32 * ks + 8 * g) * 2);
            const bool do_store = (n >= 4 || ctx_out);
#pragma unroll
            for (int li = 0; li < 4; ++li) {
                const float pl = ((const LAS float*)(W + ML_CUM))[16 * li + r] + m, dmx = ((const LAS float*)(W + ML_DMX))[16 * li + r];
                const float mrow = fmaxf(pl, dmx), f1 = __expf(dmx - mrow), f2 = __expf(pl - mrow), cv = __expf(-mrow);
                pg8::f32x4 DI = MFMA16(nf[0], qf[li][0], zero4); DI = MFMA16(nf[1], qf[li][1], DI);
                const float den = f1 * dl[li] + f2 * DI[0];
                const float inv = 1.f / fmaxf(fabsf(den), cv);
                bf16* orow = OM + ((size_t)dir * MT + (size_t)(roff + rsgn * (16 * li + r))) * 256 + h * 64 + 4 * g;
#pragma unroll
                for (int dt = 0; dt < 4; ++dt) {
                    const bf16x8v c0 = *(const LAS bf16x8v*)(W + ML_KW + (16 * dt + r) * 128 + (8 * g) * 2), c1 = *(const LAS bf16x8v*)(W + ML_KW + (16 * dt + r) * 128 + (32 + 8 * g) * 2);
                    pg8::f32x4 Tt = MFMA16(c0, qf[li][0], zero4); Tt = MFMA16(c1, qf[li][1], Tt);
                    const pg8::f32x4 o = (O[dt][li] * f1 + Tt * f2) * inv;
                    if (do_store) { v2u w; w.x = pg8::cvt_pk_safe(o[0], o[1]); w.y = pg8::cvt_pk_safe(o[2], o[3]); *(v2u*)(orow + 16 * dt) = w; } }
            }
        }
    }
}


constexpr int SG_STRIDE = 544;
__device__ __forceinline__ void sgu_unit(LAS unsigned char* lds, unsigned char* ws, const bf16* WSG, const float* sb, const int row0, const int tid, const int wave, const int lane) {
    const bf16* P = (const bf16*)(ws + WS_P); bf16* HM = (bf16*)(ws + WS_HM);
    {
        const int sp = tid >> 2, qd = tid & 3; const bf16* src = P + (size_t)(row0 + sp) * NP + PC_SV + 64 * qd;
        v4u x[8]; float sum = 0.f;
#pragma unroll
        for (int i = 0; i < 8; ++i) { x[i] = *(const v4u*)(src + 8 * i); sum += (bflo(x[i].x) + bfhi(x[i].x)) + (bflo(x[i].y) + bfhi(x[i].y)) + (bflo(x[i].z) + bfhi(x[i].z)) + (bflo(x[i].w) + bfhi(x[i].w)); }
        sum = quad_sum4(sum);
        const float mu = sum * (1.f / 256.f); float sq = 0.f;
#pragma unroll
        for (int i = 0; i < 8; ++i) { const unsigned ww[4] = {x[i].x, x[i].y, x[i].z, x[i].w};
#pragma unroll
            for (int q = 0; q < 4; ++q) { const float a = bflo(ww[q]) - mu, c = bfhi(ww[q]) - mu; sq += a * a + c * c; } }
        sq = quad_sum4(sq);
        const float rstd = rsqrtf(sq * (1.f / 256.f) + EPS);
#pragma unroll
        for (int i = 0; i < 8; ++i) { const unsigned ww[4] = {x[i].x, x[i].y, x[i].z, x[i].w}; v4u o;
            o.x = pk2((bflo(ww[0]) - mu) * rstd, (bfhi(ww[0]) - mu) * rstd); o.y = pk2((bflo(ww[1]) - mu) * rstd, (bfhi(ww[1]) - mu) * rstd);
            o.z = pk2((bflo(ww[2]) - mu) * rstd, (bfhi(ww[2]) - mu) * rstd); o.w = pk2((bflo(ww[3]) - mu) * rstd, (bfhi(ww[3]) - mu) * rstd);
            *(LAS v4u*)(lds + sp * SG_STRIDE + (64 * qd + 8 * i) * 2) = o; }
    }
    __syncthreads();
    {
        const int r = lane & 15, g = lane >> 4, q4 = r >> 2, p4 = lane & 3, gg = wave >> 1, mh = wave & 1;
        pg8::f32x4 acc[4][4];
#pragma unroll
        for (int ct = 0; ct < 4; ++ct)
#pragma unroll
            for (int lt = 0; lt < 4; ++lt) acc[ct][lt] = (pg8::f32x4){0.f, 0.f, 0.f, 0.f};
#pragma unroll
        for (int ks = 0; ks < 4; ++ks) { bf16x8v Af[4], Bf[4];
#pragma unroll
            for (int ct = 0; ct < 4; ++ct) { LAS unsigned char* a = lds + (32 * ks + 8 * g + q4) * SG_STRIDE + (gg * 64 + 16 * ct + 4 * p4) * 2; Af[ct] = cat4(tr_read(a), tr_read(a + 4 * SG_STRIDE)); }
#pragma unroll
            for (int lt = 0; lt < 4; ++lt) Bf[lt] = *(const bf16x8v*)(WSG + ((size_t)gg * 128 + 64 * mh + 16 * lt + r) * 128 + 32 * ks + 8 * g);
#pragma unroll
            for (int ct = 0; ct < 4; ++ct)
#pragma unroll
                for (int lt = 0; lt < 4; ++lt) acc[ct][lt] = MFMA16(Af[ct], Bf[lt], acc[ct][lt]); }
#pragma unroll
        for (int lt = 0; lt < 4; ++lt) { const int lpos = 64 * mh + 16 * lt + r; const size_t row = (size_t)(row0 + lpos); const float bias = sb[gg * 128 + lpos];
#pragma unroll
            for (int ct = 0; ct < 4; ++ct) { const int c = gg * 64 + 16 * ct + 4 * g; const v2u uu = *(const v2u*)(P + row * NP + PC_SU + c);
                v2u w; w.x = pg8::cvt_pk_safe(bflo(uu.x) * (acc[ct][lt][0] + bias), bfhi(uu.x) * (acc[ct][lt][1] + bias)); w.y = pg8::cvt_pk_safe(bflo(uu.y) * (acc[ct][lt][2] + bias), bfhi(uu.y) * (acc[ct][lt][3] + bias));
                *(v2u*)(HM + row * D + 512 + c) = w; } }
    }
    __syncthreads();
}

template <bool BASEF32> struct EpiRes16 {
    static constexpr bool PERM = true;
    const void* xbase; bf16* xout; const void* cbase; bf16* cout; const float* modl; int goff;
    __device__ __forceinline__ void operator()(const pg8::f32x4 (&acc)[2][2][4][2], const pg8::Unit& u, int wr, int wc, int fr, int fq) const {
        const void* basep; bf16* outp; int bidx; size_t rb;
        if (u.pm < 64) { bidx = u.pm >> 3; rb = (size_t)u.pm * 256; basep = xbase; outp = xout; } else { bidx = 8; rb = (size_t)(u.pm - 64) * 256; basep = cbase; outp = cout; }
        const float* gatep = modl + bidx * 6144 + goff;
        const int col0 = u.pn * 256 + wc * 32 + 8 * fq, r0 = wr * 64 + fr;
        pg8::f32x4 gv[2][2];
#pragma unroll
        for (int bj = 0; bj < 2; ++bj)
#pragma unroll
            for (int n = 0; n < 2; ++n) gv[bj][n] = *(const pg8::f32x4*)(gatep + col0 + bj * 128 + 4 * n);
#pragma unroll
        for (int ai = 0; ai < 2; ++ai)
#pragma unroll
            for (int m = 0; m < 4; ++m) { const size_t off = (rb + r0 + ai * 128 + m * 16) * D + col0;
#pragma unroll
                for (int bj = 0; bj < 2; ++bj) { pg8::f32x4 b0, b1;
                    if (BASEF32) { b0 = __builtin_nontemporal_load((const pg8::f32x4*)((const float*)basep + off + bj * 128)); b1 = __builtin_nontemporal_load((const pg8::f32x4*)((const float*)basep + off + bj * 128 + 4)); }
                    else { const pg8::u32x4 bw = *(const pg8::u32x4*)((const bf16*)basep + off + bj * 128);
                        b0 = (pg8::f32x4){bflo(bw.x), bfhi(bw.x), bflo(bw.y), bfhi(bw.y)}; b1 = (pg8::f32x4){bflo(bw.z), bfhi(bw.z), bflo(bw.w), bfhi(bw.w)}; }
                    const pg8::f32x4 v0 = b0 + gv[bj][0] * acc[ai][bj][m][0], v1 = b1 + gv[bj][1] * acc[ai][bj][m][1];
                    pg8::u32x4 w; w.x = pg8::cvt_pk_bf16(v0[0], v0[1]); w.y = pg8::cvt_pk_bf16(v0[2], v0[3]); w.z = pg8::cvt_pk_bf16(v1[0], v1[1]); w.w = pg8::cvt_pk_bf16(v1[2], v1[3]);
                    *(pg8::u32x4*)(outp + off + bj * 128) = w; } }
    }
};

struct Args { const float* in[25]; float* out; unsigned char* ws; int ph_lo, ph_hi, submask, pad; };

__device__ __forceinline__ void transpose_block(const float* W, int ldw, bf16* dst, int K, LAS float* scr, int lane) {
    f32x4 v[8];
#pragma unroll
    for (int i = 0; i < 8; ++i) v[i] = __builtin_nontemporal_load((const f32x4*)(W + (size_t)(8 * i + (lane >> 3)) * ldw + 4 * (lane & 7)));
#pragma unroll
    for (int i = 0; i < 8; ++i) { LAS float* p = scr + (8 * i + (lane >> 3)) * 33 + 4 * (lane & 7); p[0] = v[i].x; p[1] = v[i].y; p[2] = v[i].z; p[3] = v[i].w; }
    LDS_WAIT(); asm volatile("" ::: "memory");
    const int c = lane & 7;
#pragma unroll
    for (int j = 0; j < 4; ++j) { const int n = (lane >> 3) + 8 * j; const LAS float* s = scr + (8 * c) * 33 + n;
        v4u o; o.x = pk2(s[0 * 33], s[1 * 33]); o.y = pk2(s[2 * 33], s[3 * 33]); o.z = pk2(s[4 * 33], s[5 * 33]); o.w = pk2(s[6 * 33], s[7 * 33]);
        __builtin_nontemporal_store(o, (v4u*)(dst + (size_t)n * K + 8 * c)); }
    LDS_WAIT(); asm volatile("" ::: "memory");
}


constexpr int MOE_I_MGU = 16 * 224, MOE_I_MD = 56 * 32, MOE_ITEMS = 8 * MOE_I_MGU + 8 * MOE_I_MD;
__device__ __forceinline__ void moe_convert_range(const int lo, const int hi, const int widx, const int nw, const float* wg, const float* wu, const float* wd, unsigned char* ws, LAS float* scr, const int lane) {
    for (int it = lo + widx; it < hi; it += nw) { int r = it;
        if (r < 8 * MOE_I_MGU) { const int e = r / MOE_I_MGU; r -= e * MOE_I_MGU; const int kb = r / 224, nb = r % 224, r0 = 32 * nb, tile = r0 >> 8, half = (r0 >> 7) & 1, j = r0 & 127;
            const float* src = (half ? wu : wg) + (size_t)e * D * DFE + (size_t)(64 * kb) * DFE + 128 * tile + j;
            transpose_block(src, DFE, (bf16*)(ws + WS_WTMGU) + (size_t)e * 2 * DFE * D + (size_t)r0 * D + 64 * kb, D, scr, lane); }
        else { r -= 8 * MOE_I_MGU; const int e = r / MOE_I_MD; r -= e * MOE_I_MD; const int kb = r / 32, nb = r % 32;
            transpose_block(wd + (size_t)e * DFE * D + (size_t)(64 * kb) * D + 32 * nb, D, (bf16*)(ws + WS_WTMD) + (size_t)e * D * DFE + (size_t)(32 * nb) * DFE + 64 * kb, DFE, scr, lane); } }
}

#define AS4 __attribute__((address_space(4)))
typedef const AS4 unsigned char* kptr_t;
__device__ __forceinline__ kptr_t kargs() { kptr_t p = (kptr_t)__builtin_amdgcn_kernarg_segment_ptr(); asm volatile("" : "+s"(p)); return p; }
#define KIN(i) (*(const float* const AS4*)(ka + 8 * (i)))
#define KOUT   (*(float* const AS4*)(ka + 200))
#define KWS    (*(unsigned char* const AS4*)(ka + 208))
#define KLO    (*(const int AS4*)(ka + 216))
#define KHI    (*(const int AS4*)(ka + 220))
#define KSUB   (*(const int AS4*)(ka + 224))
#define PH_BEGIN(k) PH_BEGIN_T(k, 31)
#define PH_BEGIN_T(k, tag) { const kptr_t ka = kargs(); if (KLO <= (k) && (k) < KHI && ((KSUB >> (tag)) & 1)) { unsigned char* const ws = KWS; (void)ws; \
    int tid = threadIdx.x; asm volatile("" : "+v"(tid)); const int lane = tid & 63, wave = __builtin_amdgcn_readfirstlane(tid >> 6), G = gridDim.x, bx = blockIdx.x; \
    const int gw = bx * NWAVES + wave, NGW = G * NWAVES, gtid = bx * (NWAVES * 64) + tid, NGT = G * NWAVES * 64; (void)lane; (void)gw; (void)NGW; (void)gtid; (void)NGT;
#define PH_END } }
#define SEAM(k) { if (MK_ONE_LAUNCH) { const kptr_t ka = kargs(); if (KLO <= (k) && (k) + 1 < KHI) xcd_barrier(bar); } }
#define WSP(T, off) ((T*)(ws + (off)))

template <int l>
__device__ __forceinline__ void layer_phases(LAS unsigned char* lds, const XcdBarrier& bar) {
        const int pb = 1 + l * 16;
        const bool ctx_out = (l == 0);
        PH_BEGIN(pb + 0)
            const float* modl = WSP(float, WS_MOD) + (size_t)l * 9 * 6144;
            const float* ng = KIN(6) + l * D;
            bf16* HM = WSP(bf16, WS_HM);
            for (int row = gw; row < MT; row += NGW) {
                const float* mrow = modl + (row < MX ? (row >> 11) : 8) * 6144;
                f32x4 v[4]; float ss = 0.f;
                if (l == 0) { const float* src = row < MX ? KIN(0) + (size_t)row * D : KIN(2) + (size_t)(row - MX) * D;
#pragma unroll
                    for (int j = 0; j < 4; ++j) v[j] = __builtin_nontemporal_load((const f32x4*)(src + 4 * lane + 256 * j)); }
                else if (row < MX) { const bf16* src = WSP(bf16, WS_XS16) + (size_t)row * D;
#pragma unroll
                    for (int j = 0; j < 4; ++j) { const v2u w = *(const v2u*)(src + 4 * lane + 256 * j); v[j] = (f32x4){bflo(w.x), bfhi(w.x), bflo(w.y), bfhi(w.y)}; } }
                else { const size_t rc = (size_t)(row - MX); const bf16* src = WSP(bf16, WS_XC) + rc * D; const bf16* p0 = WSP(bf16, WS_CPART) + rc * D; const bf16* p1 = p0 + (size_t)MC * D; const float* g2p = WSP(float, WS_MOD) + 8 * 6144 + 5120;
#pragma unroll
                    for (int j = 0; j < 4; ++j) { const int c = 4 * lane + 256 * j; const v2u w = *(const v2u*)(src + c), a = *(const v2u*)(p0 + c), b2 = *(const v2u*)(p1 + c); const f32x4 g2 = *(const f32x4*)(g2p + c);
                        v[j] = (f32x4){bflo(w.x) + g2.x * (bflo(a.x) + bflo(b2.x)), bfhi(w.x) + g2.y * (bfhi(a.x) + bfhi(b2.x)), bflo(w.y) + g2.z * (bflo(a.y) + bflo(b2.y)), bfhi(w.y) + g2.w * (bfhi(a.y) + bfhi(b2.y))}; } }
#pragma unroll
                for (int j = 0; j < 4; ++j) ss += (v[j].x * v[j].x + v[j].y * v[j].y) + (v[j].z * v[j].z + v[j].w * v[j].w);
                const float rstd = rsqrtf(wave_sum(ss) * (1.f / D) + EPS);
#pragma unroll
                for (int j = 0; j < 4; ++j) { const int c = 4 * lane + 256 * j; const f32x4 g = *(const f32x4*)(ng + c), sh = *(const f32x4*)(mrow + c), sc = *(const f32x4*)(mrow + 1024 + c);
                    v[j] = v[j] * rstd * g * (sc + 1.f) + sh;
                    v2u o; o.x = pk2(v[j].x, v[j].y); o.y = pk2(v[j].z, v[j].w); *(v2u*)(HM + (size_t)row * D + c) = o; }
            }
        PH_END
        SEAM(pb + 0)
        PH_BEGIN(pb + 1)
            InProjSched S; S.init(WSP(bf16, WS_HM), WSP(bf16, WS_WTIN) + (size_t)l * NPG * D, l == 0 ? 11 : 8, G, bx);
            EpiInProj E{WSP(bf16, WS_P), WSP(float, WS_G)};
            pg8::gemm_phase<EpiInProj, InProjSched, PG8_ALIGN, PG8_SP2>(lds, D, S, E);
        PH_END
        PH_BEGIN(pb + 1)
            if (l == 0 && bx >= 24) moe_convert_range(12000, 14000, (bx - 24) * 8 + wave, 232 * 8, KIN(21), KIN(22), KIN(23), ws, (LAS float*)(lds + wave * 16384), lane);
        PH_END
        SEAM(pb + 1)
        PH_BEGIN(pb + 2)
            const bf16* P = WSP(bf16, WS_P); bf16* QK = WSP(bf16, WS_QK);
            const float* cw = KIN(13) + l * 9 * 512;
            f32x4 w0[9], w1[9];
            { const int ch = (gtid & 63) * 8;
#pragma unroll
              for (int tp = 0; tp < 9; ++tp) { w0[tp] = *(const f32x4*)(cw + tp * 512 + ch); w1[tp] = *(const f32x4*)(cw + tp * 512 + ch + 4); } }
            for (int i = gtid; i < MT * 64; i += NGT) {
                const int row = i >> 6, ch = (i & 63) * 8;
                int base, rr0, cc0, nr, nc;
                if (row < MX) { base = (row >> 11) * T; const int t = row & 2047; rr0 = t >> 6; cc0 = t & 63; nr = 32; nc = 64; }
                else { const int rc = row - MX; base = MX + (rc >> 8) * TC; rr0 = 0; cc0 = rc & 255; nr = 1; nc = 256; }
                v4u x[9];
#pragma unroll
                for (int dr = -1; dr <= 1; ++dr)
#pragma unroll
                    for (int dc = -1; dc <= 1; ++dc) { const int rr = rr0 + dr, cc = cc0 + dc; const bool ok = (unsigned)rr < (unsigned)nr && (unsigned)cc < (unsigned)nc;
                        const v4u xv = *(const v4u*)(P + (size_t)(base + (ok ? rr : rr0) * nc + (ok ? cc : cc0)) * NP + PC_MQ + ch);
                        x[(dr + 1) * 3 + (dc + 1)] = ok ? xv : (v4u){0u, 0u, 0u, 0u}; }
                float y[8];
#pragma unroll
                for (int j = 0; j < 8; ++j) y[j] = 0.f;
#pragma unroll
                for (int tp = 0; tp < 9; ++tp) { y[0] += bflo(x[tp].x) * w0[tp].x; y[1] += bfhi(x[tp].x) * w0[tp].y; y[2] += bflo(x[tp].y) * w0[tp].z; y[3] += bfhi(x[tp].y) * w0[tp].w;
                    y[4] += bflo(x[tp].z) * w1[tp].x; y[5] += bfhi(x[tp].z) * w1[tp].y; y[6] += bflo(x[tp].w) * w1[tp].z; y[7] += bfhi(x[tp].w) * w1[tp].w; }
                v4u o; o.x = pk2(siluf_(y[0]), siluf_(y[1])); o.y = pk2(siluf_(y[2]), siluf_(y[3])); o.z = pk2(siluf_(y[4]), siluf_(y[5])); o.w = pk2(siluf_(y[6]), siluf_(y[7]));
                *(v4u*)(QK + (size_t)row * 512 + ch) = o;
            }
        PH_END
        PH_BEGIN(pb + 2)
            const bf16* P = WSP(bf16, WS_P); const bf16* TWCH = WSP(bf16, WS_TWCH);
            const int r = lane & 15, g = lane >> 4; LAS unsigned char* W = lds + wave * WAVE_LDS;
            const int nitems = ctx_out ? (MT / 64) * 4 : (MX / 64) * 4;
            for (int it = gw; it < nitems; it += NGW) {
                const int blk = it >> 2, gg = it & 3, row0 = blk * 64;
                bf16* fb; int Tn, t0;
                if (row0 < MX) { const int b = row0 >> 11; t0 = row0 & 2047; Tn = T; fb = WSP(bf16, WS_FBX) + ((size_t)b * 256 + gg * 64) * 4096; }
                else { const int rc = row0 - MX, b = rc >> 8; t0 = rc & 255; Tn = TC; fb = WSP(bf16, WS_FBC) + ((size_t)b * 256 + gg * 64) * 512; }
                bf16x8v Af[4][2];
#pragma unroll
                for (int i = 0; i < 4; ++i)
#pragma unroll
                    for (int ks = 0; ks < 2; ++ks) Af[i][ks] = *(const bf16x8v*)(P + (size_t)(row0 + 16 * i + r) * NP + PC_F + gg * 64 + 32 * ks + 8 * g);
#pragma unroll
                for (int nt = 0; nt < 8; ++nt) { const bf16x8v b0 = *(const bf16x8v*)(TWCH + (16 * nt + r) * 64 + 8 * g), b1 = *(const bf16x8v*)(TWCH + (16 * nt + r) * 64 + 32 + 8 * g);
#pragma unroll
                    for (int i = 0; i < 4; ++i) { pg8::f32x4 d = MFMA16(Af[i][0], b0, ((pg8::f32x4){0.f, 0.f, 0.f, 0.f})); d = MFMA16(Af[i][1], b1, d);
                        v2u w; w.x = pg8::cvt_pk_safe(d[0], d[1]); w.y = pg8::cvt_pk_safe(d[2], d[3]); *(LAS v2u*)(W + (16 * nt + r) * 144 + (16 * i + 4 * g) * 2) = w; } }
#pragma unroll
                for (int j = 0; j < 16; ++j) { const int np = j * 8 + (lane >> 3); const v4u x = *(const LAS v4u*)(W + np * 144 + (lane & 7) * 16);
                    *(v4u*)(fb + (size_t)(np & 63) * (2 * Tn) + (np >= 64 ? Tn : 0) + t0 + (lane & 7) * 8) = x; }
            }
        PH_END
        SEAM(pb + 2)
        PH_BEGIN_T(pb + 3, 0)
            if (bx < 64) gla_scan<l>(lds, ws, KIN(10), KIN(11), bx, wave, lane, ctx_out);
        PH_END
        PH_BEGIN_T(pb + 3, 1)
            if (bx >= 64 && bx < 128) mlstm_scan<l>(lds, ws, KIN(14), bx - 64, wave, lane, ctx_out);
        PH_END
        PH_BEGIN_T(pb + 3, 2)
            if (bx >= 192) {
                const bf16* WSG = WSP(bf16, WS_WSGU) + (size_t)l * 4 * 128 * 128; const float* sb = KIN(16) + l * 4 * 128;
                const int nunits = ctx_out ? 144 : 128;
                for (int u = bx - 192; u < nunits; u += 64) sgu_unit(lds, ws, WSG, sb, u < 128 ? u * 128 : MX + (u - 128) * 128, tid, wave, lane);
            }
        PH_END
        PH_BEGIN_T(pb + 3, 3)
            BatchSched S{(const char*)WSP(bf16, WS_TWX), (const char*)WSP(bf16, WS_FBX), (size_t)256 * 4096 * 2, (size_t)256 * 4096 * 2, (size_t)2048 * 2, 128, 8, G, bx - 128};
            EpiFourier E{WSP(bf16, WS_HM) + 768, D, (size_t)T * D, WSP(bf16, WS_MIXB), 256, (size_t)T * 256};
            pg8::gemm_phase<EpiFourier, BatchSched, PG8_ALIGN, PG8_SP2>(lds, 2048, S, E, 4096);
        PH_END
        if (ctx_out) {
        PH_BEGIN_T(pb + 3, 4)
            BatchSched S{(const char*)WSP(bf16, WS_TWC), (const char*)WSP(bf16, WS_FBC), (size_t)256 * 512 * 2, (size_t)256 * 512 * 2, (size_t)256 * 2, 16, 1, G, bx - 128};
            EpiFourier E{WSP(bf16, WS_HM) + (size_t)MX * D + 768, D, (size_t)TC * D, WSP(bf16, WS_MIXB) + (size_t)MX * 256, 256, (size_t)TC * 256};
            pg8::gemm_phase<EpiFourier, BatchSched, PG8_ALIGN, PG8_SP2>(lds, 256, S, E, 512);
        PH_END
        }
        PH_BEGIN(pb + 3)
            if (bx >= 192) moe_convert_range(l == 0 ? 0 : 4000, l == 0 ? 4000 : 8000, (bx - 192) * 8 + wave, 64 * 8, KIN(21), KIN(22), KIN(23), ws, (LAS float*)(lds + wave * 16384), lane);
            if (bx >= 128 && bx < 192) moe_convert_range(l == 0 ? 8000 : 39000, l == 0 ? 12000 : MOE_ITEMS, (bx - 128) * 8 + wave, 64 * 8, KIN(21), KIN(22), KIN(23), ws, (LAS float*)(lds + wave * 16384), lane);
        PH_END
        SEAM(pb + 3)
        PH_BEGIN(pb + 4)
            const bf16* P = WSP(bf16, WS_P); const bf16* OG = WSP(bf16, WS_OG); const bf16* OM = WSP(bf16, WS_OM); bf16* HM = WSP(bf16, WS_HM); const bf16* MIXB = WSP(bf16, WS_MIXB);
            const float* gng = KIN(12) + l * 256;
            constexpr int NB = (l == 0) ? 3 : 4, NIT = (l == 0) ? 3 : 2;
            const int c = 4 * lane; const f32x4 ng = *(const f32x4*)(gng + c);
            for (int it = 0; it < NIT; ++it) {
                v2u of[NB], ob[NB], gg[NB], hf[NB], hb[NB], og[NB], fa[NB], fb[NB];
#pragma unroll
                for (int k = 0; k < NB; ++k) { const size_t row = (size_t)(gw + (it * NB + k) * NGW);
                    of[k] = __builtin_nontemporal_load((const v2u*)(OG + row * 256 + c)); ob[k] = __builtin_nontemporal_load((const v2u*)(OG + ((size_t)MT + row) * 256 + c));
                    hf[k] = __builtin_nontemporal_load((const v2u*)(OM + row * 256 + c)); hb[k] = __builtin_nontemporal_load((const v2u*)(OM + ((size_t)MT + row) * 256 + c));
                    gg[k] = *(const v2u*)(P + row * NP + PC_GG + c); og[k] = *(const v2u*)(P + row * NP + PC_MO + c);
                    fa[k] = *(const v2u*)(HM + row * D + 768 + c); fb[k] = __builtin_nontemporal_load((const v2u*)(MIXB + row * 256 + c)); }
#pragma unroll
                for (int k = 0; k < NB; ++k) { const size_t row = (size_t)(gw + (it * NB + k) * NGW);
                    const float o0 = bflo(of[k].x) + bflo(ob[k].x), o1 = bfhi(of[k].x) + bfhi(ob[k].x), o2 = bflo(of[k].y) + bflo(ob[k].y), o3 = bfhi(of[k].y) + bfhi(ob[k].y);
                    float ss = (o0 * o0 + o1 * o1) + (o2 * o2 + o3 * o3);
                    ss = row_sum16(ss);
                    const float rs = rsqrtf(ss * (1.f / 64.f) + EPS);
                    v2u w; w.x = pk2(o0 * rs * ng.x * siluf_(bflo(gg[k].x)), o1 * rs * ng.y * siluf_(bfhi(gg[k].x))); w.y = pk2(o2 * rs * ng.z * siluf_(bflo(gg[k].y)), o3 * rs * ng.w * siluf_(bfhi(gg[k].y)));
                    *(v2u*)(HM + row * D + c) = w;
                    v2u w2; w2.x = pk2(sigmoidf_(bflo(og[k].x)) * (bflo(hf[k].x) + bflo(hb[k].x)), sigmoidf_(bfhi(og[k].x)) * (bfhi(hf[k].x) + bfhi(hb[k].x)));
                    w2.y = pk2(sigmoidf_(bflo(og[k].y)) * (bflo(hf[k].y) + bflo(hb[k].y)), sigmoidf_(bfhi(og[k].y)) * (bfhi(hf[k].y) + bfhi(hb[k].y)));
                    *(v2u*)(HM + row * D + 256 + c) = w2;
                    v2u w3; w3.x = pk2(bflo(fa[k].x) + bflo(fb[k].x), bfhi(fa[k].x) + bfhi(fb[k].x)); w3.y = pk2(bflo(fa[k].y) + bflo(fb[k].y), bfhi(fa[k].y) + bfhi(fb[k].y)); *(v2u*)(HM + row * D + 768 + c) = w3; }
            }
        PH_END
        SEAM(pb + 4)
        PH_BEGIN(pb + 5)
            DenseSched S; S.init(WSP(bf16, WS_HM), WSP(bf16, WS_WTOUT) + (size_t)l * D * D, MX / 256, D / 256, D, G, bx);
            if (l == 0) { EpiRes16<true> E{KIN(0), WSP(bf16, WS_XS16), KIN(2), WSP(bf16, WS_XC), WSP(float, WS_MOD), 2048};
                pg8::gemm_phase<EpiRes16<true>, DenseSched, PG8_ALIGN, PG8_SP2>(lds, D, S, E);
                CtxSplitSched S2{(const char*)(WSP(bf16, WS_HM) + (size_t)MX * D), (const char*)WSP(bf16, WS_WTOUT), (size_t)256 * D * 2, (size_t)512 * 2, G, (bx + 128) & 255};
                EpiKSplit E2{WSP(bf16, WS_CPART), (size_t)MC * D};
                pg8::gemm_phase<EpiKSplit, CtxSplitSched, PG8_ALIGN, PG8_SP2>(lds, 512, S2, E2, D); }
            else { EpiRes16<false> E{WSP(bf16, WS_XS16), WSP(bf16, WS_XS16), WSP(bf16, WS_XC), WSP(bf16, WS_XC), WSP(float, WS_MOD) + (size_t)9 * 6144, 2048};
                pg8::gemm_phase<EpiRes16<false>, DenseSched, PG8_ALIGN, PG8_SP2>(lds, D, S, E); }
        PH_END
        PH_BEGIN(pb + 5)
            if (false) moe_convert_range(0, 0, 0, 1, KIN(21), KIN(22), KIN(23), ws, (LAS float*)(lds + wave * 16384), lane);
        PH_END
        SEAM(pb + 5)
        PH_BEGIN(pb + 6)
            const bf16* xs = WSP(bf16, WS_XS16); const bf16* XC = WSP(bf16, WS_XC); const float* modl = WSP(float, WS_MOD) + (size_t)l * 9 * 6144; bf16* HM = WSP(bf16, WS_HM);
            const float* ng = KIN(7) + l * D; const float* moe_router = KIN(20);
            float* RG = WSP(float, WS_ROUTE + 65536); int* RE = WSP(int, WS_ROUTE); int* RP = WSP(int, WS_ROUTE + 65536 * 3);
            LAS int* lcnt = (LAS int*)lds; LAS int* wgb = lcnt + 8; LAS int* rinfo = lcnt + 16;
            if (l == 1) { if (tid < 16) lcnt[tid] = 0; __syncthreads(); }
            const int nrows = ctx_out ? MT : MX, rpw = nrows / NGW;
            for (int ri = 0; ri < rpw; ++ri) {
                const int row = gw + ri * NGW;
                const float* mrow = modl + (row < MX ? (row >> 11) : 8) * 6144;
                f32x4 v[4]; float ss = 0.f;
                if (row < MX) { const bf16* src = xs + (size_t)row * D;
#pragma unroll
                    for (int j = 0; j < 4; ++j) { const v2u w = *(const v2u*)(src + 4 * lane + 256 * j); v[j] = (f32x4){bflo(w.x), bfhi(w.x), bflo(w.y), bfhi(w.y)}; } }
                else { const size_t rc = (size_t)(row - MX); const float* cin = KIN(2) + rc * D; const bf16* p0 = WSP(bf16, WS_CPART) + rc * D; const bf16* p1 = p0 + (size_t)MC * D; bf16* xcw = WSP(bf16, WS_XC) + rc * D;
#pragma unroll
                    for (int j = 0; j < 4; ++j) { const int c = 4 * lane + 256 * j; const v2u a = *(const v2u*)(p0 + c), b2 = *(const v2u*)(p1 + c); const f32x4 g1 = *(const f32x4*)(mrow + 2048 + c), ci = *(const f32x4*)(cin + c);
                        const f32x4 pp = {bflo(a.x) + bflo(b2.x), bfhi(a.x) + bfhi(b2.x), bflo(a.y) + bflo(b2.y), bfhi(a.y) + bfhi(b2.y)};
                        v2u o; o.x = pk2(ci.x + g1.x * pp.x, ci.y + g1.y * pp.y); o.y = pk2(ci.z + g1.z * pp.z, ci.w + g1.w * pp.w); *(v2u*)(xcw + c) = o;
                        v[j] = (f32x4){bflo(o.x), bfhi(o.x), bflo(o.y), bfhi(o.y)}; } }
#pragma unroll
                for (int j = 0; j < 4; ++j) ss += (v[j].x * v[j].x + v[j].y * v[j].y) + (v[j].z * v[j].z + v[j].w * v[j].w);
                const float rstd = rsqrtf(wave_sum(ss) * (1.f / D) + EPS);
#pragma unroll
                for (int j = 0; j < 4; ++j) { const int c = 4 * lane + 256 * j; const f32x4 g = *(const f32x4*)(ng + c), sh = *(const f32x4*)(mrow + 3072 + c), sc = *(const f32x4*)(mrow + 4096 + c);
                    v[j] = v[j] * rstd * g * (sc + 1.f) + sh;
                    v2u o; o.x = pk2(v[j].x, v[j].y); o.y = pk2(v[j].z, v[j].w); *(v2u*)(HM + (size_t)row * D + c) = o; }
                if (l == 1) {
                    float lg[8];
#pragma unroll
                    for (int e = 0; e < 8; ++e) lg[e] = 0.f;
#pragma unroll
                    for (int j = 0; j < 4; ++j) { const float vv[4] = {v[j].x, v[j].y, v[j].z, v[j].w};
#pragma unroll
                        for (int q = 0; q < 4; ++q) { const float* wr_ = moe_router + (size_t)(4 * lane + 256 * j + q) * 8; const f32x4 w0 = *(const f32x4*)wr_, w1 = *(const f32x4*)(wr_ + 4);
                            lg[0] += vv[q] * w0.x; lg[1] += vv[q] * w0.y; lg[2] += vv[q] * w0.z; lg[3] += vv[q] * w0.w; lg[4] += vv[q] * w1.x; lg[5] += vv[q] * w1.y; lg[6] += vv[q] * w1.z; lg[7] += vv[q] * w1.w; } }
#pragma unroll
                    for (int e = 0; e < 8; ++e) lg[e] = wave_sum(lg[e]);
                    float v0 = lg[0]; int e0 = 0;
#pragma unroll
                    for (int e = 1; e < 8; ++e) if (lg[e] > v0) { v0 = lg[e]; e0 = e; }
                    float v1 = -3.0e38f; int e1 = 0;
#pragma unroll
                    for (int e = 0; e < 8; ++e) if (e != e0 && lg[e] > v1) { v1 = lg[e]; e1 = e; }
                    if (lane == 0) { const float g0 = 1.f / (1.f + __expf(v1 - v0));
                        RG[row * 2] = g0; RG[row * 2 + 1] = 1.f - g0;
                        const int lp0 = __hip_atomic_fetch_add(&lcnt[e0], 1, __ATOMIC_RELAXED, __HIP_MEMORY_SCOPE_WORKGROUP);
                        const int lp1 = __hip_atomic_fetch_add(&lcnt[e1], 1, __ATOMIC_RELAXED, __HIP_MEMORY_SCOPE_WORKGROUP);
                        const int lr = wave * rpw + ri; rinfo[lr * 4] = e0; rinfo[lr * 4 + 1] = e1; rinfo[lr * 4 + 2] = lp0; rinfo[lr * 4 + 3] = lp1; }
                }
            }
            if (l == 1) {
                __syncthreads();
                if (tid < 8) wgb[tid] = (int)__hip_atomic_fetch_add((unsigned*)(ws + WS_CTL) + CW_CNT + tid * 64, (unsigned)lcnt[tid], RLX_AGENT);
                __syncthreads();
                if (tid < 64) { const int row = bx * 8 + (tid >> 3) + (tid & 7) * NGW; const int e0 = rinfo[tid * 4], e1 = rinfo[tid * 4 + 1];
                    RE[row] = e0 | (e1 << 8); RP[row * 2] = wgb[e0] + rinfo[tid * 4 + 2]; RP[row * 2 + 1] = wgb[e1] + rinfo[tid * 4 + 3]; }
                __syncthreads();
            }
        PH_END
        SEAM(pb + 6)
        if (l == 0) {
            PH_BEGIN(pb + 7)
                DenseSched S; S.init(WSP(bf16, WS_HM), WSP(bf16, WS_WTGU), MT / 256, 2 * DFF / 256, D, G, bx);
                EpiSwiGLU E{WSP(bf16, WS_ACTF), DFF};
                pg8::gemm_phase<EpiSwiGLU, DenseSched, PG8_ALIGN, PG8_SP2>(lds, D, S, E);
            PH_END
            PH_BEGIN(pb + 7)
                if (bx >= 48) moe_convert_range(14000, 24000, (bx - 48) * 8 + wave, 208 * 8, KIN(21), KIN(22), KIN(23), ws, (LAS float*)(lds + wave * 16384), lane);
            PH_END
            SEAM(pb + 7)
            PH_BEGIN(pb + 8)
                DenseSched S; S.init(WSP(bf16, WS_ACTF), WSP(bf16, WS_WTD), MX / 256, D / 256, DFF, G, bx);
                EpiRes16<false> E{WSP(bf16, WS_XS16), WSP(bf16, WS_XS16), WSP(bf16, WS_XC), WSP(bf16, WS_XC), WSP(float, WS_MOD), 5120};
                pg8::gemm_phase<EpiRes16<false>, DenseSched, PG8_ALIGN, PG8_SP2>(lds, DFF, S, E);
                CtxSplitSched S2{(const char*)(WSP(bf16, WS_ACTF) + (size_t)MX * DFF), (const char*)WSP(bf16, WS_WTD), (size_t)256 * DFF * 2, (size_t)1408 * 2, G, (bx + 128) & 255};
                EpiKSplit E2{WSP(bf16, WS_CPART), (size_t)MC * D};
                pg8::gemm_phase<EpiKSplit, CtxSplitSched, PG8_ALIGN, PG8_SP2>(lds, 1408, S2, E2, DFF);
            PH_END
            PH_BEGIN(pb + 8)
                if (bx < 128 || bx >= 192) moe_convert_range(24000, 39000, (bx < 128 ? bx : bx - 64) * 8 + wave, 192 * 8, KIN(21), KIN(22), KIN(23), ws, (LAS float*)(lds + wave * 16384), lane);
            PH_END
            SEAM(pb + 8)
        } else {
            PH_BEGIN(pb + 7)
                const bf16* HM = WSP(bf16, WS_HM); bf16* XS = WSP(bf16, WS_XS); const int* RE = WSP(int, WS_ROUTE); const int* RP = WSP(int, WS_ROUTE + 65536 * 3); int* RS = WSP(int, WS_ROUTE + 65536 * 5);
                int tbA[8];
                { int a0 = 0;
#pragma unroll
                  for (int e = 0; e < 8; ++e) { tbA[e] = a0; a0 += ((int)__builtin_amdgcn_readfirstlane(__hip_atomic_load((unsigned*)(ws + WS_CTL) + CW_CNT + e * 64, RLX_AGENT)) + 255) >> 8; } }
                for (int it = 0; it < 2; ++it) {
                    int ee[4], rp0[4], rp1[4]; v4u a[4], b2[4];
#pragma unroll
                    for (int k = 0; k < 4; ++k) { const int row = gw + (it * 4 + k) * NGW; ee[k] = RE[row]; rp0[k] = RP[row * 2]; rp1[k] = RP[row * 2 + 1];
                        a[k] = __builtin_nontemporal_load((const v4u*)(HM + (size_t)row * D + 8 * lane)); b2[k] = __builtin_nontemporal_load((const v4u*)(HM + (size_t)row * D + 512 + 8 * lane)); }
#pragma unroll
                    for (int k = 0; k < 4; ++k) { const int row = gw + (it * 4 + k) * NGW; const int e0 = ee[k] & 255, e1 = ee[k] >> 8;
                        int tb0 = 0, tb1 = 0;
#pragma unroll
                        for (int e = 0; e < 8; ++e) { tb0 = (e == e0) ? tbA[e] : tb0; tb1 = (e == e1) ? tbA[e] : tb1; }
                        const int s0 = tb0 * 256 + rp0[k], s1 = tb1 * 256 + rp1[k];
                        *(v4u*)(XS + (size_t)s0 * D + 8 * lane) = a[k]; *(v4u*)(XS + (size_t)s0 * D + 512 + 8 * lane) = b2[k];
                        *(v4u*)(XS + (size_t)s1 * D + 8 * lane) = a[k]; *(v4u*)(XS + (size_t)s1 * D + 512 + 8 * lane) = b2[k];
                        if (lane == 0) { RS[row * 2] = s0; RS[row * 2 + 1] = s1; } }
                }
            PH_END
            SEAM(pb + 7)
#pragma unroll
            for (int ps = 0; ps < 2; ++ps) {
                PH_BEGIN(pb + 8 + 2 * ps)
                    MoeSched S; S.W = (const char*)(ws + WS_WTMGU); S.tstepA = (size_t)256 * D * 2; S.tstepW = (size_t)256 * D * 2; S.estride = (size_t)2 * DFE * D * 2;
                    { int a0 = 0;
#pragma unroll
                      for (int e = 0; e < 8; ++e) { S.tb[e] = a0; a0 += ((int)__builtin_amdgcn_readfirstlane(__hip_atomic_load((unsigned*)(ws + WS_CTL) + CW_CNT + e * 64, RLX_AGENT)) + 255) >> 8; }
                      S.tb[8] = a0; }
                    S.t0 = MOE_PASS * ps; int nt = S.tb[8] - S.t0; if (ps == 0) nt = nt > MOE_PASS ? MOE_PASS : nt;
                    if (nt > 0) {
                        S.A = (const char*)(ws + WS_XS) + (size_t)S.t0 * S.tstepA; S.o.init(nt, 2 * DFE / 256, G, bx);
                        EpiSwiGLU E{WSP(bf16, WS_ACTM), DFE};
                        pg8::gemm_phase<EpiSwiGLU, MoeSched, PG8_ALIGN, PG8_SP2>(lds, D, S, E);
                    }
                PH_END
                SEAM(pb + 8 + 2 * ps)
                PH_BEGIN(pb + 9 + 2 * ps)
                    MoeSched S; S.A = (const char*)(ws + WS_ACTM); S.W = (const char*)(ws + WS_WTMD); S.tstepA = (size_t)256 * DFE * 2; S.tstepW = (size_t)256 * DFE * 2; S.estride = (size_t)D * DFE * 2;
                    { int a0 = 0;
#pragma unroll
                      for (int e = 0; e < 8; ++e) { S.tb[e] = a0; a0 += ((int)__builtin_amdgcn_readfirstlane(__hip_atomic_load((unsigned*)(ws + WS_CTL) + CW_CNT + e * 64, RLX_AGENT)) + 255) >> 8; }
                      S.tb[8] = a0; }
                    S.t0 = MOE_PASS * ps; int nt = S.tb[8] - S.t0; nt = nt > MOE_PASS ? MOE_PASS : nt;
                    if (nt > 0) {
                        S.o.init(nt, D / 256, G, bx);
                        EpiBf16Plain E{WSP(bf16, WS_XS) + (size_t)S.t0 * 256 * D, D, 0};
                        pg8::gemm_phase<EpiBf16Plain, MoeSched, PG8_ALIGN, PG8_SP2>(lds, DFE, S, E);
                    }
                PH_END
                if (ps == 1) {
                PH_BEGIN(pb + 9 + 2 * ps)
                    KSplitSched S; S.A = (const char*)(ws + WS_ACTM) + (size_t)64 * 256 * DFE * 2; S.W = (const char*)(ws + WS_WTMD); S.tstepA = (size_t)256 * DFE * 2; S.tstepW = (size_t)256 * DFE * 2; S.estride = (size_t)D * DFE * 2;
                    { int a0 = 0;
#pragma unroll
                      for (int e = 0; e < 8; ++e) { S.tb[e] = a0; a0 += ((int)__builtin_amdgcn_readfirstlane(__hip_atomic_load((unsigned*)(ws + WS_CTL) + CW_CNT + e * 64, RLX_AGENT)) + 255) >> 8; }
                      S.tb[8] = a0; }
                    const int nleft = S.tb[8] - 128;
                    if (nleft > 0) {
                        S.nunits = nleft * 16; S.G = G; S.c = (bx + 128) & 255;
                        EpiKSplit E{WSP(bf16, WS_YLP), (size_t)8 * 256 * D};
                        pg8::gemm_phase<EpiKSplit, KSplitSched, PG8_ALIGN, PG8_SP2>(lds, 896, S, E, DFE);
                    }
                PH_END
                }
                SEAM(pb + 9 + 2 * ps)
            }
            PH_BEGIN(pb + 14)
                float* xs = KOUT; const bf16* XS16 = WSP(bf16, WS_XS16); const float* modl = WSP(float, WS_MOD) + (size_t)9 * 6144; const float* final_norm_g = KIN(24);
                const int* RS = WSP(int, WS_ROUTE + 65536 * 5); const float* RG = WSP(float, WS_ROUTE + 65536); const bf16* Yh = WSP(bf16, WS_XS); const bf16* YLP = WSP(bf16, WS_YLP);
                for (int it = 0; it < 4; ++it) {
                    int s0[2], s1[2]; float g0[2], g1[2];
#pragma unroll
                    for (int k = 0; k < 2; ++k) { const int row = gw + (it * 2 + k) * NGW; s0[k] = RS[row * 2]; s1[k] = RS[row * 2 + 1]; g0[k] = RG[row * 2]; g1[k] = RG[row * 2 + 1]; }
                    v2u y0[2][4], y1[2][4], xw[2][4];
#pragma unroll
                    for (int k = 0; k < 2; ++k) { const int row = gw + (it * 2 + k) * NGW; const int c0 = s0[k] < 128 * 256 ? s0[k] : 0, c1 = s1[k] < 128 * 256 ? s1[k] : 0;
#pragma unroll
                        for (int j = 0; j < 4; ++j) { const int c = 4 * lane + 256 * j;
                            y0[k][j] = __builtin_nontemporal_load((const v2u*)(Yh + (size_t)c0 * D + c)); y1[k][j] = __builtin_nontemporal_load((const v2u*)(Yh + (size_t)c1 * D + c));
                            xw[k][j] = __builtin_nontemporal_load((const v2u*)(XS16 + (size_t)row * D + c)); } }
#pragma unroll
                    for (int k = 0; k < 2; ++k) { const int row = gw + (it * 2 + k) * NGW;
                        const float* mrow = modl + (row >> 11) * 6144 + 5120;
                        f32x4 v[4]; float ss = 0.f;
#pragma unroll
                        for (int j = 0; j < 4; ++j) { const int c = 4 * lane + 256 * j;
                            f32x4 ya = {bflo(y0[k][j].x), bfhi(y0[k][j].x), bflo(y0[k][j].y), bfhi(y0[k][j].y)}, yb = {bflo(y1[k][j].x), bfhi(y1[k][j].x), bflo(y1[k][j].y), bfhi(y1[k][j].y)};
                            if (s0[k] >= 128 * 256) { ya = (f32x4){0.f, 0.f, 0.f, 0.f};
#pragma unroll
                                for (int k4 = 0; k4 < 4; ++k4) { const v2u t = *(const v2u*)(YLP + ((size_t)k4 * 2048 + (s0[k] - 128 * 256)) * D + c); ya += (f32x4){bflo(t.x), bfhi(t.x), bflo(t.y), bfhi(t.y)}; } }
                            if (s1[k] >= 128 * 256) { yb = (f32x4){0.f, 0.f, 0.f, 0.f};
#pragma unroll
                                for (int k4 = 0; k4 < 4; ++k4) { const v2u t = *(const v2u*)(YLP + ((size_t)k4 * 2048 + (s1[k] - 128 * 256)) * D + c); yb += (f32x4){bflo(t.x), bfhi(t.x), bflo(t.y), bfhi(t.y)}; } }
                            const f32x4 xv = {bflo(xw[k][j].x), bfhi(xw[k][j].x), bflo(xw[k][j].y), bfhi(xw[k][j].y)}, g2 = *(const f32x4*)(mrow + c);
                            const f32x4 y = ya * g0[k] + yb * g1[k];
                            v[j] = xv + g2 * y; ss += (v[j].x * v[j].x + v[j].y * v[j].y) + (v[j].z * v[j].z + v[j].w * v[j].w); }
                        const float rstd = rsqrtf(wave_sum(ss) * (1.f / D) + EPS);
#pragma unroll
                        for (int j = 0; j < 4; ++j) { const int c = 4 * lane + 256 * j; const f32x4 g = *(const f32x4*)(final_norm_g + c); __builtin_nontemporal_store(v[j] * rstd * g, (f32x4*)(xs + (size_t)row * D + c)); } }
                }
            PH_END
        }
    }

__global__ void __launch_bounds__(NWAVES * 64, 2) fwd(Args args_unused) {
    extern __shared__ __attribute__((aligned(16))) unsigned char lds_raw[];
    LAS unsigned char* lds = (LAS unsigned char*)lds_raw;
    for (int u = threadIdx.x; u < (LDS_BYTES - LDSCTL_OFF) / 4; u += NWAVES * 64) ((LAS unsigned*)(lds + LDSCTL_OFF))[u] = 0u;
    __syncthreads();
    XcdBarrier bar; bar.bar = nullptr; bar.x = 0; bar.st = nullptr;
    if (MK_ONE_LAUNCH) { const kptr_t ka = kargs(); bar = xcd_barrier_post((unsigned*)(KWS + WS_CTL) + CW_BAR, (volatile LAS unsigned*)(lds + MISC_OFF) + 8); }

    PH_BEGIN(0)
        LAS float* scr = (LAS float*)(lds + wave * 16384);
        const float* w_in = KIN(8); const float* w_out = KIN(9);
        constexpr int I_IN = 16 * 80, I_OUT = 16 * 32, I_GU = 16 * 176, I_D = 44 * 32;
        constexpr int NITEMS = 2 * I_IN + 2 * I_OUT + I_GU + I_D;
        for (int it = gw; it < NITEMS; it += NGW) {
            int r = it;
            if (r < 2 * I_IN) { const int l = r / I_IN; r -= l * I_IN; const int kb = r / 80, nb = r % 80; const int sc = 32 * nb + (nb >= 24 ? 32 : 0) + (nb >= 56 ? 16 : 0);
                transpose_block(w_in + (size_t)l * D * D_IN + (size_t)(64 * kb) * D_IN + sc, D_IN, WSP(bf16, WS_WTIN) + (size_t)l * NPG * D + (size_t)(32 * nb) * D + 64 * kb, D, scr, lane); continue; }
            r -= 2 * I_IN;
            if (r < 2 * I_OUT) { const int l = r / I_OUT; r -= l * I_OUT; const int kb = r / 32, nb = r % 32;
                transpose_block(w_out + (size_t)l * D * D + (size_t)(64 * kb) * D + 32 * nb, D, WSP(bf16, WS_WTOUT) + (size_t)l * D * D + (size_t)(32 * nb) * D + 64 * kb, D, scr, lane); continue; }
            r -= 2 * I_OUT;
            if (r < I_GU) { const int kb = r / 176, nb = r % 176, r0 = 32 * nb, tile = r0 >> 8, half = (r0 >> 7) & 1, j = r0 & 127;
                const float* src = (half ? KIN(18) : KIN(17)) + (size_t)(64 * kb) * DFF + 128 * tile + j;
                transpose_block(src, DFF, WSP(bf16, WS_WTGU) + (size_t)r0 * D + 64 * kb, D, scr, lane); continue; }
            r -= I_GU;
            if (r < I_D) { const int kb = r / 32, nb = r % 32;
                transpose_block(KIN(19) + (size_t)(64 * kb) * D + 32 * nb, D, WSP(bf16, WS_WTD) + (size_t)(32 * nb) * DFF + 64 * kb, DFF, scr, lane); continue; }
        }
        { bf16* WTIN = WSP(bf16, WS_WTIN);
          for (int i = gtid; i < 2 * 256 * D; i += NGT) { const int l = i / (256 * D), j = (i / D) & 255, k = i % D; const int oc = j < 32 ? 768 + j : 1824 + (j - 32);
            WTIN[(size_t)l * NPG * D + (size_t)(NP + j) * D + k] = j < NG ? (bf16)f2bf(w_in[(size_t)l * D * D_IN + (size_t)k * D_IN + oc]) : (bf16)0; }
          bf16* WSG = WSP(bf16, WS_WSGU); const float* sw = KIN(15);
          for (int i = gtid; i < 2 * 4 * 128 * 128; i += NGT) WSG[i] = (bf16)f2bf(sw[i]); }
        { bf16* TWX = WSP(bf16, WS_TWX); bf16* TWC = WSP(bf16, WS_TWC);
          for (int i = gtid; i < 2048 * 4096; i += NGT) { const int k = i >> 12, t = i & 4095, j = (k * (t & 2047)) & 2047; const float ang = (float)j * (6.283185307179586f / 2048.f);
            const float v = (t < 2048 ? __cosf(ang) : __sinf(ang)) * 0.0027621358640099515f; TWX[i] = (bf16)f2bf(v); }
          for (int i = gtid; i < 256 * 512; i += NGT) { const int k = i >> 9, t = i & 511, j = (k * (t & 255)) & 255; const float ang = (float)j * (6.283185307179586f / 256.f);
            const float v = (t < 256 ? __cosf(ang) : __sinf(ang)) * 0.0078125f; TWC[i] = (bf16)f2bf(v); } }
        { bf16* TWCH = WSP(bf16, WS_TWCH);
          for (int i = gtid; i < 128 * 64; i += NGT) { const int np = i >> 6, c = i & 63, m = np & 63; const float ang = (float)((m * c) & 63) * (6.283185307179586f / 64.f);
            TWCH[i] = (bf16)f2bf(np < 64 ? __cosf(ang) : -__sinf(ang)); } }
        __syncthreads();
        if (bx < 192) {
            const float* c_in = KIN(1); const float* cctx_in = KIN(3); const float* w_ada = KIN(4); const float* b_ada = KIN(5); float* MOD = WSP(float, WS_MOD);
            LAS float* sil = (LAS float*)lds; LAS float* red = (LAS float*)(lds + 36864);
            for (int i = tid; i < 9 * D; i += NWAVES * 64) { const int b = i >> 10, k = i & 1023; const float v = b < 8 ? c_in[b * D + k] : cctx_in[k]; sil[i] = siluf_(v); }
            __syncthreads();
            const int l = bx / 96, col = (bx % 96) * 64 + lane;
            const float* W = w_ada + (size_t)l * D * 6144 + col;
            float acc[9];
#pragma unroll
            for (int b = 0; b < 9; ++b) acc[b] = 0.f;
            for (int k0 = wave * 128; k0 < wave * 128 + 128; k0 += 16) { float w[16];
#pragma unroll
                for (int kk = 0; kk < 16; ++kk) w[kk] = __builtin_nontemporal_load(W + (size_t)(k0 + kk) * 6144);
#pragma unroll 4
                for (int kk = 0; kk < 16; ++kk)
#pragma unroll
                    for (int b = 0; b < 9; ++b) acc[b] += sil[b * D + k0 + kk] * w[kk]; }
#pragma unroll
            for (int b = 0; b < 9; ++b) red[(wave * 9 + b) * 64 + lane] = acc[b];
            __syncthreads();
            if (wave == 0) {
#pragma unroll
                for (int b = 0; b < 9; ++b) { float s = b_ada[l * 6144 + col];
#pragma unroll
                    for (int w = 0; w < 8; ++w) s += red[(w * 9 + b) * 64 + lane];
                    MOD[(size_t)(l * 9 + b) * 6144 + col] = s; } }
            __syncthreads();
        }
    PH_END
    SEAM(0)

    layer_phases<0>(lds, bar);
    layer_phases<1>(lds, bar);
}

extern "C" void kernel_launch(void* const* d_in, const int* in_sizes, int n_in, void* d_out, int out_size, void* d_ws, size_t ws_size, hipStream_t stream) {
    static int grid = 0;
    if (grid == 0) {
        if (n_in != 25 || out_size != MX * D || ws_size < WS_END) { fprintf(stderr, "kernel_launch: unexpected problem (n_in %d out %d ws %zu need %zu)\n", n_in, out_size, ws_size, (size_t)WS_END); grid = -1; return; }
        int dev = 0, cus = 0, per_cu = 0;
        if (hipGetDevice(&dev) != hipSuccess || hipDeviceGetAttribute(&cus, hipDeviceAttributeMultiprocessorCount, dev) != hipSuccess) { grid = -1; return; }
        if (hipFuncSetAttribute((const void*)fwd, hipFuncAttributeMaxDynamicSharedMemorySize, LDS_BYTES) != hipSuccess) { grid = -1; return; }
        if (hipOccupancyMaxActiveBlocksPerMultiprocessor(&per_cu, (const void*)fwd, NWAVES * 64, LDS_BYTES) != hipSuccess || per_cu < 1) { fprintf(stderr, "kernel_launch: occupancy query says %d\n", per_cu); }
        (void)hipGetLastError();
        grid = cus;
        if (grid != 256) { fprintf(stderr, "kernel_launch: built for 256 CUs, got %d\n", grid); grid = -1; return; }
    }
    if (grid < 0) return;
    if (hipMemsetAsync((char*)d_ws + WS_CTL, 0, CTL_ZERO_BYTES, stream) != hipSuccess) return;
    Args a{};
    for (int i = 0; i < 25; ++i) a.in[i] = (const float*)d_in[i];
    a.out = (float*)d_out; a.ws = (unsigned char*)d_ws;
    constexpr int NPH = 33;
    a.submask = -1; a.pad = 0;
#if MK_ONE_LAUNCH
    a.ph_lo = 0; a.ph_hi = NPH;
    hipLaunchKernelGGL(fwd, dim3(grid), dim3(NWAVES * 64), LDS_BYTES, stream, a);
#else
    for (int p = 0; p < NPH; ++p) {
        if (p >= 10 && p <= 16) continue;
        if (p >= 32) continue;
        a.ph_lo = p; a.ph_hi = p + 1; a.submask = -1;
        hipLaunchKernelGGL(fwd, dim3(grid), dim3(NWAVES * 64), LDS_BYTES, stream, a);
#ifdef PROBE_PH
        if (p == PROBE_PH) { a.submask = PROBE_SUBMASK; for (int k = 0; k < PROBE_REPS; ++k) hipLaunchKernelGGL(fwd, dim3(grid), dim3(NWAVES * 64), LDS_BYTES, stream, a); }
#endif
    }
#endif
}
```

```cpp
#include <hip/hip_runtime.h>
#include <cstdio>
#include <cstdint>

#ifndef MK_ONE_LAUNCH
#define MK_ONE_LAUNCH 1
#endif

namespace pg8 {
#define PG8_LAS __attribute__((address_space(3)))
typedef unsigned short bf16_t;
typedef short bf16x8 __attribute__((ext_vector_type(8)));
typedef float f32x4 __attribute__((ext_vector_type(4)));
typedef float f32x2 __attribute__((ext_vector_type(2)));
typedef unsigned u32x4 __attribute__((ext_vector_type(4)));
constexpr int BM = 256, BK = 64, HALF = 128, HTB = HALF * BK * 2, STAGE_BYTES = 8 * HTB, NXCD = 8, WGM = 8;

__host__ __device__ __forceinline__ int lds_byte(int r, int c) { const int st = (r >> 4) * 2 + (c >> 5), rr = r & 15, cc = c & 31, ob = rr * 64 + cc * 2; return st * 1024 + (ob ^ (((ob >> 9) & 1) << 5)); }
__host__ __device__ __forceinline__ void stage_rc(int b, int& R, int& C) { const int st = b / 1024, sb = b % 1024, swz = sb ^ (((sb >> 9) & 1) << 5); R = (st >> 1) * 16 + swz / 64; C = (st & 1) * 32 + (swz % 64) / 2; }
__host__ __device__ __forceinline__ int perm32(int rho) { const int n = rho >> 4, i = rho & 15; return 8 * (i >> 2) + 4 * n + (i & 3); }

struct Unit { int pm, pn, z; };

struct StaticOrder {
    int nM, nN, nwg, G, c;
    __host__ __device__ void init(int nM_, int nN_, int G_, int c_) { nM = nM_; nN = nN_; nwg = nM * nN; G = G_; c = c_; }
    __host__ __device__ bool next(int i, Unit& u) const {
        const long L = (long)i * G + c; if (L >= nwg) return false;
        int wgid = (int)L; { const int q = nwg / NXCD, r = nwg % NXCD, xcd = wgid % NXCD, off = wgid / NXCD; wgid = (xcd < r ? xcd * (q + 1) : r * (q + 1) + (xcd - r) * q) + off; }
        const int nig = WGM * nN, gid = wgid / nig, fm = gid * WGM, gsz = (nM - fm) < WGM ? (nM - fm) : WGM;
        u.pm = fm + ((wgid % nig) % gsz); u.pn = (wgid % nig) / gsz; u.z = 0; return true;
    }
};

typedef __bf16 bf16v2_t __attribute__((ext_vector_type(2)));
__device__ __forceinline__ unsigned cvt_pk_safe(float lo, float hi) { const bf16v2_t v = __builtin_convertvector((f32x2){lo, hi}, bf16v2_t); return __builtin_bit_cast(unsigned, v); }
__device__ __forceinline__ unsigned cvt_pk_bf16(float lo, float hi) { return cvt_pk_safe(lo, hi); }

template <class Epi, class Sched, bool ALIGN_EPI = false, bool SP2 = false>
__device__ __forceinline__ void gemm_phase(PG8_LAS unsigned char* lds, const int K, const Sched& S, const Epi& E, const int pitch_ = 0) {
    const int tid = threadIdx.x, wid = __builtin_amdgcn_readfirstlane(tid >> 6), lane = tid & 63, wr = wid >> 2, wc = wid & 3, fr = lane & 15, fq = lane >> 4;
    const int nt = K / BK, pitch = pitch_ ? pitch_ : K;
    unsigned voffA[2], voffB[2];
#pragma unroll
    for (int i = 0; i < 2; ++i) { int R, C; stage_rc(tid * 16 + i * 8192, R, C); const int Rb = Epi::PERM ? ((R & ~31) + perm32(R & 31)) : R;
        voffA[i] = (unsigned)(R * pitch + C) * 2u; voffB[i] = (unsigned)(Rb * pitch + C) * 2u; }
    const size_t kstep = (size_t)(BK * 2);
    const size_t hstep = (size_t)HALF * pitch * 2;
    const unsigned ldsw = (unsigned)wid * 1024u;
    const int aoff = lds_byte(wr * 64 + fr, fq * 8), boff = lds_byte(wc * 32 + fr, fq * 8);
#define PG8_SA(b, h) (((b) * 2 + (h)) * HTB)
#define PG8_SB(b, h) ((4 + (b) * 2 + (h)) * HTB)
#define PG8_STAGE(bufoff, gbase, voff) do { _Pragma("unroll") for (int _i = 0; _i < 2; ++_i) \
        __builtin_amdgcn_global_load_lds((const unsigned*)((const char*)(gbase) + (voff)[_i]), (PG8_LAS unsigned*)(lds + (bufoff) + ldsw + _i * 8192), 16, 0, 0); } while (0)
#define PG8_LDA(dst, b, h) do { _Pragma("unroll") for (int m = 0; m < 4; ++m) _Pragma("unroll") for (int k = 0; k < 2; ++k) dst[m][k] = *(const PG8_LAS bf16x8*)(lds + PG8_SA(b, h) + aoff + m * 2048 + k * 1024); } while (0)
#define PG8_LDB(dst, b, h) do { _Pragma("unroll") for (int n = 0; n < 2; ++n) _Pragma("unroll") for (int k = 0; k < 2; ++k) dst[n][k] = *(const PG8_LAS bf16x8*)(lds + PG8_SB(b, h) + boff + n * 2048 + k * 1024); } while (0)
#define PG8_MMA(ai, bj, At, Bt) do { __builtin_amdgcn_s_setprio(1); _Pragma("unroll") for (int m = 0; m < 4; ++m) _Pragma("unroll") for (int n = 0; n < 2; ++n) _Pragma("unroll") for (int k = 0; k < 2; ++k) \
        acc[ai][bj][m][n] = __builtin_amdgcn_mfma_f32_16x16x32_bf16(Bt[n][k], At[m][k], acc[ai][bj][m][n], 0, 0, 0); __builtin_amdgcn_s_setprio(0); } while (0)
#define PG8_WAIT_V(n) asm volatile("s_waitcnt vmcnt(" #n ")" ::: "memory")
#define PG8_WAIT_L(n) asm volatile("s_waitcnt lgkmcnt(" #n ")" ::: "memory")
#define PG8_BAR __builtin_amdgcn_s_barrier()
#define PG8_SCHED __builtin_amdgcn_sched_barrier(0)
    Unit cur, nxt; int ui = 0;
    if (!S.next(0, cur)) return;
    f32x4 acc[2][2][4][2];
#pragma unroll
    for (int a = 0; a < 2; ++a)
#pragma unroll
        for (int b = 0; b < 2; ++b)
#pragma unroll
            for (int m = 0; m < 4; ++m)
#pragma unroll
                for (int n = 0; n < 2; ++n) acc[a][b][m][n] = (f32x4){0.f, 0.f, 0.f, 0.f};
    bf16x8 At[4][2], B0[2][2], B1[2][2];
    const char* cA = S.aptr(cur); const char* cB = S.bptr(cur);
    if constexpr (SP2) {
        PG8_STAGE(PG8_SB(0, 0), cB, voffB); PG8_STAGE(PG8_SB(0, 1), cB + hstep, voffB); PG8_STAGE(PG8_SA(0, 0), cA, voffA); PG8_STAGE(PG8_SA(0, 1), cA + hstep, voffA);
        if (wr == 1) PG8_BAR;
        PG8_WAIT_V(2); PG8_BAR;
        PG8_STAGE(PG8_SB(1, 0), cB + kstep, voffB); PG8_STAGE(PG8_SA(1, 0), cA + kstep, voffA); PG8_STAGE(PG8_SB(1, 1), cB + hstep + kstep, voffB);
        PG8_WAIT_V(6); PG8_BAR;
    } else {
        PG8_STAGE(PG8_SB(0, 0), cB, voffB); PG8_STAGE(PG8_SA(0, 0), cA, voffA); PG8_STAGE(PG8_SB(0, 1), cB + hstep, voffB); PG8_STAGE(PG8_SA(0, 1), cA + hstep, voffA);
        if (wr == 1) PG8_BAR;
        PG8_WAIT_V(4); PG8_BAR;
        PG8_STAGE(PG8_SB(1, 0), cB + kstep, voffB); PG8_STAGE(PG8_SA(1, 0), cA + kstep, voffA); PG8_STAGE(PG8_SB(1, 1), cB + hstep + kstep, voffB);
        PG8_WAIT_V(6); PG8_BAR;
    }
    for (;;) {
        const bool has_next = S.next(ui + 1, nxt);
        const char* nA = has_next ? S.aptr(nxt) : cA; const char* nB = has_next ? S.bptr(nxt) : cB;
        for (int t = 0; t < nt; t += 2) {
            const bool last = (t == nt - 2);
            const char* a1 = cA + (size_t)(t + 1) * kstep;
            const char* a2 = last ? nA : cA + (size_t)(t + 2) * kstep; const char* b2 = last ? nB : cB + (size_t)(t + 2) * kstep;
            const char* a3 = a2 + kstep; const char* b3 = b2 + kstep;
            if constexpr (SP2) {
            PG8_LDB(B0, 0, 0); PG8_LDB(B1, 0, 1); PG8_SCHED; PG8_LDA(At, 0, 0); PG8_STAGE(PG8_SA(1, 1), a1 + hstep, voffA);
            PG8_WAIT_V(8); PG8_WAIT_L(0); PG8_BAR; PG8_MMA(0, 0, At, B0); PG8_MMA(0, 1, At, B1); PG8_BAR; PG8_SCHED;
            PG8_LDA(At, 0, 1); PG8_STAGE(PG8_SB(0, 0), b2, voffB); PG8_STAGE(PG8_SB(0, 1), b2 + hstep, voffB); PG8_STAGE(PG8_SA(0, 0), a2, voffA);
            PG8_WAIT_V(8); PG8_WAIT_L(0); PG8_BAR; PG8_MMA(1, 0, At, B0); PG8_MMA(1, 1, At, B1); PG8_BAR; PG8_SCHED;
            PG8_LDB(B0, 1, 0); PG8_LDB(B1, 1, 1); PG8_SCHED; PG8_LDA(At, 1, 0); PG8_STAGE(PG8_SA(0, 1), a2 + hstep, voffA);
            PG8_WAIT_V(8); PG8_WAIT_L(0); PG8_BAR; PG8_MMA(0, 0, At, B0); PG8_MMA(0, 1, At, B1); PG8_BAR; PG8_SCHED;
            PG8_LDA(At, 1, 1); PG8_STAGE(PG8_SB(1, 0), b3, voffB); PG8_STAGE(PG8_SB(1, 1), b3 + hstep, voffB); PG8_STAGE(PG8_SA(1, 0), a3, voffA);
            PG8_WAIT_V(8); PG8_WAIT_L(0); PG8_BAR; PG8_MMA(1, 0, At, B0); PG8_MMA(1, 1, At, B1); PG8_BAR; PG8_SCHED;
            } else {
            PG8_LDB(B0, 0, 0); PG8_SCHED; PG8_LDA(At, 0, 0); PG8_STAGE(PG8_SA(1, 1), a1 + hstep, voffA);
            PG8_WAIT_L(8); PG8_BAR; PG8_WAIT_L(0); PG8_MMA(0, 0, At, B0); PG8_BAR; PG8_SCHED;
            PG8_LDB(B1, 0, 1); PG8_STAGE(PG8_SB(0, 0), b2, voffB);
            PG8_BAR; PG8_WAIT_L(0); PG8_MMA(0, 1, At, B1); PG8_BAR;
            PG8_LDA(At, 0, 1); PG8_STAGE(PG8_SA(0, 0), a2, voffA);
            PG8_BAR; PG8_WAIT_L(0); PG8_MMA(1, 0, At, B0); PG8_BAR; PG8_SCHED;
            PG8_STAGE(PG8_SB(0, 1), b2 + hstep, voffB);
            PG8_WAIT_V(6); PG8_BAR; PG8_MMA(1, 1, At, B1); PG8_BAR;
            PG8_LDB(B0, 1, 0); PG8_SCHED; PG8_LDA(At, 1, 0); PG8_STAGE(PG8_SA(0, 1), a2 + hstep, voffA);
            PG8_WAIT_L(8); PG8_BAR; PG8_WAIT_L(0); PG8_MMA(0, 0, At, B0); PG8_BAR; PG8_SCHED;
            PG8_LDB(B1, 1, 1); PG8_STAGE(PG8_SB(1, 0), b3, voffB);
            PG8_BAR; PG8_WAIT_L(0); PG8_MMA(0, 1, At, B1); PG8_BAR;
            PG8_LDA(At, 1, 1); PG8_STAGE(PG8_SA(1, 0), a3, voffA);
            PG8_BAR; PG8_WAIT_L(0); PG8_MMA(1, 0, At, B0); PG8_BAR; PG8_SCHED;
            PG8_STAGE(PG8_SB(1, 1), b3 + hstep, voffB);
            PG8_WAIT_V(6); PG8_BAR; PG8_MMA(1, 1, At, B1); PG8_BAR;
            }
        }
        if constexpr (ALIGN_EPI) { if (wr == 0) PG8_BAR; }
        E(acc, cur, wr, wc, fr, fq);
        if (!has_next) break;
#pragma unroll
        for (int a = 0; a < 2; ++a)
#pragma unroll
            for (int b = 0; b < 2; ++b)
#pragma unroll
                for (int m = 0; m < 4; ++m)
#pragma unroll
                    for (int n = 0; n < 2; ++n) acc[a][b][m][n] = (f32x4){0.f, 0.f, 0.f, 0.f};
        cur = nxt; cA = nA; cB = nB; ++ui;
        if constexpr (ALIGN_EPI) { if (wr == 1) PG8_BAR; }
    }
    PG8_WAIT_V(0);
    if constexpr (!ALIGN_EPI) { if (wr == 0) PG8_BAR; }
    PG8_BAR;
#undef PG8_SA
#undef PG8_SB
#undef PG8_STAGE
#undef PG8_LDA
#undef PG8_LDB
#undef PG8_MMA
#undef PG8_WAIT_V
#undef PG8_WAIT_L
#undef PG8_BAR
#undef PG8_SCHED
}
}

#ifndef PG8_SP2
#define PG8_SP2 true
#endif
#ifndef PG8_ALIGN
#define PG8_ALIGN true
#endif

constexpr int NWAVES = 8;
constexpr int D = 1024, NB = 8, T = 2048, TC = 256, MX = NB * T, MC = NB * TC, MT = MX + MC;
constexpr int D_IN = 2608, NP = 2560, NPG = 2816, NG = 48, DFF = 2816, DFE = 3584, NE = 8;
constexpr float EPS = 1e-6f;
constexpr int PC_GQ = 0, PC_GK = 128, PC_GV = 256, PC_GG = 512, PC_MQ = 768, PC_MK = 1024, PC_MV = 1280, PC_MO = 1536, PC_SU = 1792, PC_SV = 2048, PC_F = 2304;
constexpr int MOE_TILES = 136, MOE_PASS = 64;

constexpr size_t MiB = 1u << 20;
constexpr size_t WS_CTL = 0, CTL_ZERO_BYTES = 1 * MiB;
constexpr size_t WS_MOD = 1 * MiB;
constexpr size_t WS_ROUTE = 2 * MiB;
constexpr size_t WS_WSGU = 3 * MiB;
constexpr size_t WS_TWCH = 4 * MiB;
constexpr size_t WS_XC = 5 * MiB;
constexpr size_t WS_WTIN = 13 * MiB;
constexpr size_t WS_WTOUT = 24 * MiB;
constexpr size_t WS_WTGU = 28 * MiB;
constexpr size_t WS_WTD = 39 * MiB;
constexpr size_t WS_WTMGU = 45 * MiB;
constexpr size_t WS_WTMD = 157 * MiB;
constexpr size_t WS_R = 213 * MiB;
constexpr size_t WS_HM = WS_R + 0 * MiB;
constexpr size_t WS_P = WS_R + 36 * MiB;
constexpr size_t WS_G = WS_R + 126 * MiB;
constexpr size_t WS_QK = WS_R + 130 * MiB;
constexpr size_t WS_OG = WS_R + 148 * MiB;
constexpr size_t WS_OM = WS_R + 166 * MiB;
constexpr size_t WS_FBX = WS_R + 184 * MiB;
constexpr size_t WS_FBC = WS_R + 200 * MiB;
constexpr size_t WS_TWX = WS_R + 202 * MiB;
constexpr size_t WS_TWC = WS_R + 218 * MiB;
constexpr size_t WS_CPART = WS_R + 219 * MiB;
constexpr size_t WS_SCRG = WS_R + 219 * MiB;
constexpr size_t WS_SCRM = WS_R + 224 * MiB;
constexpr size_t WS_ACTF = WS_R + 36 * MiB;
constexpr size_t WS_XS = WS_R + 36 * MiB;
constexpr size_t WS_ACTM = WS_R + 104 * MiB;
constexpr size_t WS_YLP = WS_R + 0 * MiB;
constexpr size_t WS_MIXB = WS_R + 234 * MiB;
constexpr size_t WS_XS16 = WS_R + 244 * MiB;
constexpr size_t WS_END = WS_R + 276 * MiB;
constexpr int CW_BAR = 4096;
constexpr int CW_CNT = 16384;

constexpr int RING_BYTES = 131072, WAVE_LDS = 19968, LDSCTL_OFF = 8 * WAVE_LDS, MISC_OFF = LDSCTL_OFF + 320, LDS_BYTES = 163840;
static_assert(MISC_OFF + 128 <= LDS_BYTES && RING_BYTES <= LDSCTL_OFF, "LDS map");

#define GAS __attribute__((address_space(1)))
#define LAS __attribute__((address_space(3)))
typedef unsigned short bf16;
typedef unsigned v4u __attribute__((ext_vector_type(4)));
typedef unsigned v2u __attribute__((ext_vector_type(2)));
typedef float f32x4 __attribute__((ext_vector_type(4)));
typedef GAS unsigned gu32;
#define RLX_AGENT __ATOMIC_RELAXED, __HIP_MEMORY_SCOPE_AGENT
#define LDS_WAIT() asm volatile("s_waitcnt lgkmcnt(0)" ::: "memory")
__device__ __forceinline__ unsigned f2bf(float f) { unsigned u = __builtin_bit_cast(unsigned, f); return (u + 0x7fffu + ((u >> 16) & 1u)) >> 16; }
__device__ __forceinline__ unsigned pk2(float lo, float hi) { return f2bf(lo) | (f2bf(hi) << 16); }
__device__ __forceinline__ float bf2f(bf16 b) { return __builtin_bit_cast(float, ((unsigned)b) << 16); }
__device__ __forceinline__ float bflo(unsigned w) { return __builtin_bit_cast(float, w << 16); }
__device__ __forceinline__ float bfhi(unsigned w) { return __builtin_bit_cast(float, w & 0xffff0000u); }
constexpr float LOG2E = 1.4426950408889634f;
__device__ __forceinline__ float ex2(float x) { return __builtin_amdgcn_exp2f(x); }
__device__ __forceinline__ float lg2(float x) { return __builtin_amdgcn_logf(x); }
__device__ __forceinline__ float sigmoidf_(float x) { return 1.f / (1.f + __expf(-x)); }
__device__ __forceinline__ float siluf_(float x) { return x / (1.f + __expf(-x)); }
__device__ __forceinline__ float logsigmoidf_(float x) { return fminf(x, 0.f) - log1pf(__expf(-fabsf(x))); }
__device__ __forceinline__ float wave_sum(float v) {
#define WS_DPP(x, ctrl, rmask, bc) __builtin_bit_cast(float, __builtin_amdgcn_update_dpp(0, __builtin_bit_cast(int, (x)), (ctrl), (rmask), 0xf, (bc)))
    v += WS_DPP(v, 0x111, 0xf, true); v += WS_DPP(v, 0x112, 0xf, true); v += WS_DPP(v, 0x114, 0xf, true); v += WS_DPP(v, 0x118, 0xf, true);
    v += WS_DPP(v, 0x142, 0xa, false); v += WS_DPP(v, 0x143, 0xc, false);
#undef WS_DPP
    return __builtin_bit_cast(float, __builtin_amdgcn_readlane(__builtin_bit_cast(int, v), 63));
}

#define XB_TMO      128
#define XB_XCNT(j)  (256  + 64 * (j))
#define XB_XSUB(j)  (1280 + 64 * (j))
#define XB_XGEN(j)  (2304 + 64 * (j))
#define XB_TOP      3328
#define XB_TOPGEN   3392
#define XCD_BAR_WORDS 3456
#define XB_SPIN_CAP (1u << 18)
__device__ __forceinline__ unsigned xb_ld(unsigned* p)              { return __hip_atomic_load(p, __ATOMIC_RELAXED, __HIP_MEMORY_SCOPE_AGENT); }
__device__ __forceinline__ unsigned xb_add(unsigned* p, unsigned v) { return __hip_atomic_fetch_add(p, v, __ATOMIC_RELAXED, __HIP_MEMORY_SCOPE_AGENT); }
__device__ __forceinline__ unsigned xb_xcc_id() { return (unsigned)__builtin_amdgcn_s_getreg((3 << 11) | 20) & 0xFu; }
#define XB_SPIN(cond, bar) do { unsigned _sp = 0; while (cond) { __builtin_amdgcn_s_sleep(1); \
    if ((++_sp & 255u) == 0u) { if (xb_ld(&(bar)[XB_TMO])) break; if (_sp > XB_SPIN_CAP) { atomicAdd(&(bar)[XB_TMO], 1u); break; } } } } while (0)
struct XcdBarrier { unsigned* bar; unsigned x; volatile LAS unsigned* st; };
__device__ __forceinline__ XcdBarrier xcd_barrier_post(unsigned* bar, volatile LAS unsigned* st) {
    XcdBarrier b; b.bar = bar; b.x = xb_xcc_id(); b.st = st;
    if (threadIdx.x == 0) (void)xb_add(&bar[XB_XCNT(b.x)], 1u);
    return b;
}
__device__ __forceinline__ void xcd_barrier_complete(unsigned* bar, unsigned x, unsigned& nloc, unsigned& nx) {
    const unsigned G = gridDim.x * gridDim.y * gridDim.z;
    unsigned sum, cnt, mine, sp = 0u;
    for (;;) {
        sum = 0u; cnt = 0u; mine = 0u;
#pragma unroll
        for (unsigned j = 0; j < 16; ++j) { const unsigned c = xb_ld(&bar[XB_XCNT(j)]); sum += c; cnt += (c > 0u) ? 1u : 0u; mine = (j == x) ? c : mine; }
        if (sum == G) break;
        __builtin_amdgcn_s_sleep(1);
        if ((++sp & 255u) == 0u) { if (xb_ld(&bar[XB_TMO])) break; if (sp > XB_SPIN_CAP) { atomicAdd(&bar[XB_TMO], 1u); break; } }
    }
    nloc = mine > 0u ? mine : 1u; nx = cnt > 0u ? cnt : 1u;
}
__device__ __forceinline__ void xcd_barrier(const XcdBarrier& b) {
    asm volatile("s_waitcnt vmcnt(0)" ::: "memory");
    __syncthreads();
    if (threadIdx.x == 0) {
        unsigned* bar = b.bar;
        __builtin_amdgcn_s_waitcnt(0);
        unsigned nloc = b.st[0], nx = b.st[1];
        if (nloc == 0u) { xcd_barrier_complete(bar, b.x, nloc, nx); b.st[0] = nloc; b.st[1] = nx; }
        const unsigned old = xb_add(&bar[XB_XSUB(b.x)], 1u);
        const unsigned gen = old / nloc;
        if (old + 1u == (gen + 1u) * nloc) {
            __builtin_amdgcn_fence(__ATOMIC_RELEASE, "agent");
            asm volatile("s_waitcnt vmcnt(0)" ::: "memory");
            const unsigned og = xb_add(&bar[XB_TOP], 1u);
            const unsigned tg = og / nx;
            if (og + 1u == (tg + 1u) * nx) xb_add(&bar[XB_TOPGEN], 1u);
            else XB_SPIN(xb_ld(&bar[XB_TOPGEN]) == tg, bar);
            __builtin_amdgcn_fence(__ATOMIC_ACQUIRE, "agent");
            xb_add(&bar[XB_XGEN(b.x)], 1u);
            asm volatile("s_waitcnt vmcnt(0)" ::: "memory");
        } else {
            XB_SPIN(xb_ld(&bar[XB_XGEN(b.x)]) == gen, bar);
            __builtin_amdgcn_fence(__ATOMIC_ACQUIRE, "agent");
            asm volatile("s_waitcnt vmcnt(0)" ::: "memory");
        }
    }
    __syncthreads();
}

struct DenseSched {
    const char* A; const char* Bt; size_t tstep; pg8::StaticOrder o;
    __device__ __forceinline__ void init(const void* A_, const void* Bt_, int nM, int nN, int K, int G, int c) { A = (const char*)A_; Bt = (const char*)Bt_; tstep = (size_t)256 * K * 2; o.init(nM, nN, G, c); }
    __device__ __forceinline__ bool next(int i, pg8::Unit& u) const { return o.next(i, u); }
    __device__ __forceinline__ const char* aptr(const pg8::Unit& u) const { return A + (size_t)u.pm * tstep; }
    __device__ __forceinline__ const char* bptr(const pg8::Unit& u) const { return Bt + (size_t)u.pn * tstep; }
};
struct InProjSched {
    const char* A; const char* Bt; size_t tstep; int nctx, G, c; pg8::StaticOrder o;
    __device__ __forceinline__ void init(const void* A_, const void* Bt_, int nctx_, int G_, int c_) { A = (const char*)A_; Bt = (const char*)Bt_; tstep = (size_t)256 * D * 2; nctx = nctx_; G = G_; c = c_; o.init(64, 11, G_, c_); }
    __device__ __forceinline__ bool next(int i, pg8::Unit& u) const {
        if (o.next(i, u)) return true;
        const int L = i * G + c - 64 * 11; if (L >= 8 * nctx) return false;
        u.pm = 64 + L / nctx; const int q = L % nctx; u.pn = (nctx == 11 || q < 7) ? q : 10; u.z = 0; return true; }
    __device__ __forceinline__ const char* aptr(const pg8::Unit& u) const { return A + (size_t)u.pm * tstep; }
    __device__ __forceinline__ const char* bptr(const pg8::Unit& u) const { return Bt + (size_t)u.pn * tstep; }
};
struct BatchSched {
    const char* A; const char* Bt; size_t tstep, zstride, hbytes; int nunits, npm, G, c;
    __device__ __forceinline__ bool next(int i, pg8::Unit& u) const { const int L = i * G + c; if (L < 0 || L >= nunits) return false; u.z = L / (2 * npm); const int rem = L % (2 * npm); u.pm = rem >> 1; u.pn = rem & 1; return true; }
    __device__ __forceinline__ const char* aptr(const pg8::Unit& u) const { return A + (size_t)u.pm * tstep + (size_t)u.pn * hbytes; }
    __device__ __forceinline__ const char* bptr(const pg8::Unit& u) const { return Bt + (size_t)u.z * zstride + (size_t)u.pn * hbytes; }
};
struct EpiFourier {
    static constexpr bool PERM = true;
    bf16* O0; int ld0; size_t zs0; bf16* O1; int ld1; size_t zs1;
    __device__ __forceinline__ void operator()(const pg8::f32x4 (&acc)[2][2][4][2], const pg8::Unit& u, int wr, int wc, int fr, int fq) const {
        const int row0 = u.pm * 256 + wr * 64 + fr, col0 = wc * 32 + 8 * fq; const int ldc = u.pn ? ld1 : ld0; bf16* base = u.pn ? O1 + (size_t)u.z * zs1 : O0 + (size_t)u.z * zs0;
#pragma unroll
        for (int ai = 0; ai < 2; ++ai)
#pragma unroll
            for (int m = 0; m < 4; ++m) { bf16* rowp = base + (size_t)(row0 + ai * 128 + m * 16) * ldc + col0;
#pragma unroll
                for (int bj = 0; bj < 2; ++bj) { const pg8::f32x4 v0 = acc[ai][bj][m][0], v1 = acc[ai][bj][m][1];
                    pg8::u32x4 w; w.x = pg8::cvt_pk_bf16(v0[0], v0[1]); w.y = pg8::cvt_pk_bf16(v0[2], v0[3]); w.z = pg8::cvt_pk_bf16(v1[0], v1[1]); w.w = pg8::cvt_pk_bf16(v1[2], v1[3]);
                    *(pg8::u32x4*)(rowp + bj * 128) = w; } }
    }
};
struct MoeSched {
    const char* A; const char* W; size_t tstepA, tstepW, estride; int tb[9]; int t0; pg8::StaticOrder o;
    __device__ __forceinline__ bool next(int i, pg8::Unit& u) const {
        if (!o.next(i, u)) return false; const int gt = t0 + u.pm; int e = 0;
#pragma unroll
        for (int j = 1; j < 8; ++j) e += (gt >= tb[j]) ? 1 : 0;
        u.z = e; return true; }
    __device__ __forceinline__ const char* aptr(const pg8::Unit& u) const { return A + (size_t)u.pm * tstepA; }
    __device__ __forceinline__ const char* bptr(const pg8::Unit& u) const { return W + (size_t)u.z * estride + (size_t)u.pn * tstepW; }
};

struct CtxSplitSched {
    const char* A; const char* Bt; size_t tstep, kbytes; int G, c;
    __device__ __forceinline__ bool next(int i, pg8::Unit& u) const { const int L = i * G + c; if (L >= 64) return false; u.pm = L >> 3; u.pn = ((L >> 1) & 3) | ((L & 1) << 2); u.z = 0; return true; }
    __device__ __forceinline__ const char* aptr(const pg8::Unit& u) const { return A + (size_t)u.pm * tstep + (size_t)(u.pn >> 2) * kbytes; }
    __device__ __forceinline__ const char* bptr(const pg8::Unit& u) const { return Bt + (size_t)(u.pn & 3) * tstep + (size_t)(u.pn >> 2) * kbytes; }
};
struct KSplitSched {
    const char* A; const char* W; size_t tstepA, tstepW, estride; int tb[9]; int nunits, G, c;
    __device__ __forceinline__ bool next(int i, pg8::Unit& u) const {
        const int L = i * G + c; if (L >= nunits) return false; u.pm = L >> 4; u.pn = L & 15; const int gt = 128 + u.pm; int e = 0;
#pragma unroll
        for (int j = 1; j < 8; ++j) e += (gt >= tb[j]) ? 1 : 0;
        u.z = e; return true; }
    __device__ __forceinline__ const char* aptr(const pg8::Unit& u) const { return A + (size_t)u.pm * tstepA + (size_t)(u.pn >> 2) * (896 * 2); }
    __device__ __forceinline__ const char* bptr(const pg8::Unit& u) const { return W + (size_t)u.z * estride + (size_t)(u.pn & 3) * tstepW + (size_t)(u.pn >> 2) * (896 * 2); }
};
struct EpiKSplit {
    static constexpr bool PERM = true;
    bf16* O; size_t kstride;
    __device__ __forceinline__ void operator()(const pg8::f32x4 (&acc)[2][2][4][2], const pg8::Unit& u, int wr, int wc, int fr, int fq) const {
        const int row0 = u.pm * 256 + wr * 64 + fr, col0 = (u.pn & 3) * 256 + wc * 32 + 8 * fq; bf16* base = O + (size_t)(u.pn >> 2) * kstride;
#pragma unroll
        for (int ai = 0; ai < 2; ++ai)
#pragma unroll
            for (int m = 0; m < 4; ++m) { bf16* rowp = base + (size_t)(row0 + ai * 128 + m * 16) * D + col0;
#pragma unroll
                for (int bj = 0; bj < 2; ++bj) { const pg8::f32x4 v0 = acc[ai][bj][m][0], v1 = acc[ai][bj][m][1];
                    pg8::u32x4 w; w.x = pg8::cvt_pk_bf16(v0[0], v0[1]); w.y = pg8::cvt_pk_bf16(v0[2], v0[3]); w.z = pg8::cvt_pk_bf16(v1[0], v1[1]); w.w = pg8::cvt_pk_bf16(v1[2], v1[3]);
                    *(pg8::u32x4*)(rowp + bj * 128) = w; } }
    }
};
struct EpiBf16Plain {
    static constexpr bool PERM = true;
    bf16* O; int ldc; size_t zstride;
    __device__ __forceinline__ void operator()(const pg8::f32x4 (&acc)[2][2][4][2], const pg8::Unit& u, int wr, int wc, int fr, int fq) const {
        const int row0 = u.pm * 256 + wr * 64 + fr, col0 = u.pn * 256 + wc * 32 + 8 * fq; bf16* base = O + (size_t)u.z * zstride;
#pragma unroll
        for (int ai = 0; ai < 2; ++ai)
#pragma unroll
            for (int m = 0; m < 4; ++m) { bf16* rowp = base + (size_t)(row0 + ai * 128 + m * 16) * ldc + col0;
#pragma unroll
                for (int bj = 0; bj < 2; ++bj) { const pg8::f32x4 v0 = acc[ai][bj][m][0], v1 = acc[ai][bj][m][1];
                    pg8::u32x4 w; w.x = pg8::cvt_pk_bf16(v0[0], v0[1]); w.y = pg8::cvt_pk_bf16(v0[2], v0[3]); w.z = pg8::cvt_pk_bf16(v1[0], v1[1]); w.w = pg8::cvt_pk_bf16(v1[2], v1[3]);
                    *(pg8::u32x4*)(rowp + bj * 128) = w; } }
    }
};
struct EpiInProj {
    static constexpr bool PERM = true;
    bf16* O; float* GT;
    __device__ __forceinline__ void operator()(const pg8::f32x4 (&acc)[2][2][4][2], const pg8::Unit& u, int wr, int wc, int fr, int fq) const {
        const int row0 = u.pm * 256 + wr * 64 + fr;
        if (u.pn < NP / 256) {
            const int col0 = u.pn * 256 + wc * 32 + 8 * fq;
#pragma unroll
            for (int ai = 0; ai < 2; ++ai)
#pragma unroll
                for (int m = 0; m < 4; ++m) { bf16* rowp = O + (size_t)(row0 + ai * 128 + m * 16) * NP + col0;
#pragma unroll
                    for (int bj = 0; bj < 2; ++bj) { const pg8::f32x4 v0 = acc[ai][bj][m][0], v1 = acc[ai][bj][m][1];
                        pg8::u32x4 w; w.x = pg8::cvt_pk_bf16(v0[0], v0[1]); w.y = pg8::cvt_pk_bf16(v0[2], v0[3]); w.z = pg8::cvt_pk_bf16(v1[0], v1[1]); w.w = pg8::cvt_pk_bf16(v1[2], v1[3]);
                        *(pg8::u32x4*)(rowp + bj * 128) = w; } }
        } else {
            const int col0 = wc * 32 + 8 * fq;
            if (col0 < NG) {
#pragma unroll
                for (int ai = 0; ai < 2; ++ai)
#pragma unroll
                    for (int m = 0; m < 4; ++m) { float* rowp = GT + (size_t)(row0 + ai * 128 + m * 16) * NG + col0;
                        *(pg8::f32x4*)rowp = acc[ai][0][m][0]; *(pg8::f32x4*)(rowp + 4) = acc[ai][0][m][1]; } }
        }
    }
};
struct EpiSwiGLU {
    static constexpr bool PERM = true;
    bf16* O; int ldc;
    __device__ __forceinline__ void operator()(const pg8::f32x4 (&acc)[2][2][4][2], const pg8::Unit& u, int wr, int wc, int fr, int fq) const {
        const int row0 = u.pm * 256 + wr * 64 + fr, col0 = u.pn * 128 + wc * 32 + 8 * fq;
#pragma unroll
        for (int ai = 0; ai < 2; ++ai)
#pragma unroll
            for (int m = 0; m < 4; ++m) { bf16* rowp = O + (size_t)(row0 + ai * 128 + m * 16) * ldc + col0;
                float r[8];
#pragma unroll
                for (int n = 0; n < 2; ++n)
#pragma unroll
                    for (int j = 0; j < 4; ++j) { const float g = acc[ai][0][m][n][j], uu = acc[ai][1][m][n][j]; r[n * 4 + j] = g * uu * __builtin_amdgcn_rcpf(1.f + ex2(-g * LOG2E)); }
                pg8::u32x4 w; w.x = pg8::cvt_pk_bf16(r[0], r[1]); w.y = pg8::cvt_pk_bf16(r[2], r[3]); w.z = pg8::cvt_pk_bf16(r[4], r[5]); w.w = pg8::cvt_pk_bf16(r[6], r[7]);
                *(pg8::u32x4*)rowp = w; }
    }
};
struct EpiResGate {
    static constexpr bool PERM = false;
    const float* xbase; float* xout; const float* cbase; float* cout; const float* modl; int goff;
    __device__ __forceinline__ void operator()(const pg8::f32x4 (&acc)[2][2][4][2], const pg8::Unit& u, int wr, int wc, int fr, int fq) const {
        const float* basep; float* outp; int bidx;
        if (u.pm < 64) { bidx = u.pm >> 3; basep = xbase + (size_t)u.pm * 256 * D; outp = xout + (size_t)u.pm * 256 * D; }
        else { bidx = 8; basep = cbase + (size_t)(u.pm - 64) * 256 * D; outp = cout + (size_t)(u.pm - 64) * 256 * D; }
        const float* gatep = modl + bidx * 6144 + goff;
        const int col0 = u.pn * 256 + wc * 32 + 4 * fq, r0 = wr * 64 + fr;
        pg8::f32x4 gv[2][2];
#pragma unroll
        for (int bj = 0; bj < 2; ++bj)
#pragma unroll
            for (int n = 0; n < 2; ++n) gv[bj][n] = *(const pg8::f32x4*)(gatep + col0 + bj * 128 + n * 16);
#pragma unroll
        for (int ai = 0; ai < 2; ++ai)
#pragma unroll
            for (int m = 0; m < 4; ++m) { const size_t off = (size_t)(r0 + ai * 128 + m * 16) * D + col0;
#pragma unroll
                for (int bj = 0; bj < 2; ++bj)
#pragma unroll
                    for (int n = 0; n < 2; ++n) { const pg8::f32x4 bs = *(const pg8::f32x4*)(basep + off + bj * 128 + n * 16);
                        *(pg8::f32x4*)(outp + off + bj * 128 + n * 16) = bs + gv[bj][n] * acc[ai][bj][m][n]; } }
    }
};


typedef short s16x4 __attribute__((ext_vector_type(4)));
typedef short bf16x8v __attribute__((ext_vector_type(8)));
template <int CTRL> __device__ __forceinline__ float dpp_f0(float x) { return __builtin_bit_cast(float, __builtin_amdgcn_update_dpp(0, __builtin_bit_cast(int, x), CTRL, 0xf, 0xf, true)); }
template <int CTRL> __device__ __forceinline__ float dpp_fninf(float x) { return __builtin_bit_cast(float, __builtin_amdgcn_update_dpp((int)0xff800000u, __builtin_bit_cast(int, x), CTRL, 0xf, 0xf, false)); }
template <int CTRL> __device__ __forceinline__ float dpp_any(float x) { return __builtin_bit_cast(float, __builtin_amdgcn_update_dpp(0, __builtin_bit_cast(int, x), CTRL, 0xf, 0xf, false)); }
__device__ __forceinline__ float row_bcast15(float x) { return dpp_any<0x15F>(x); }
__device__ __forceinline__ float row_sum16(float x) { x += dpp_any<0x121>(x); x += dpp_any<0x122>(x); x += dpp_any<0x124>(x); x += dpp_any<0x128>(x); return x; }
__device__ __forceinline__ float quad_sum4(float x) { x += dpp_any<0xB1>(x); x += dpp_any<0x4E>(x); return x; }
__device__ __forceinline__ float lane_bcast(float x, int l) { return __builtin_bit_cast(float, __builtin_amdgcn_readlane(__builtin_bit_cast(int, x), l)); }
__device__ __forceinline__ float row_scan_add(float x) { x += dpp_f0<0x111>(x); x += dpp_f0<0x112>(x); x += dpp_f0<0x114>(x); x += dpp_f0<0x118>(x); return x; }
__device__ __forceinline__ float row_scan_max(float x) { x = fmaxf(x, dpp_fninf<0x111>(x)); x = fmaxf(x, dpp_fninf<0x112>(x)); x = fmaxf(x, dpp_fninf<0x114>(x)); x = fmaxf(x, dpp_fninf<0x118>(x)); return x; }
__device__ __forceinline__ bf16x8v pack8(const float (&v)[8]) { v4u w; w.x = pg8::cvt_pk_safe(v[0], v[1]); w.y = pg8::cvt_pk_safe(v[2], v[3]); w.z = pg8::cvt_pk_safe(v[4], v[5]); w.w = pg8::cvt_pk_safe(v[6], v[7]); return __builtin_bit_cast(bf16x8v, w); }
__device__ __forceinline__ bf16x8v cat4(s16x4 lo, s16x4 hi) { return __builtin_shufflevector(lo, hi, 0, 1, 2, 3, 4, 5, 6, 7); }
__device__ __forceinline__ s16x4 tr_read(LAS unsigned char* p) { return __builtin_amdgcn_ds_read_tr16_b64_v4i16((LAS s16x4*)p); }
#define MFMA16(a, b, c) __builtin_amdgcn_mfma_f32_16x16x32_bf16((a), (b), (c), 0, 0, 0)

constexpr int GL_V = 0, GL_K2 = 9216, GL_SC = 14336, GL_MISC = 16640;
constexpr int SCRG_SEQ = 81920;
#define WG_SYNC_GLOBAL() do { asm volatile("s_waitcnt vmcnt(0)" ::: "memory"); __syncthreads(); __builtin_amdgcn_fence(__ATOMIC_ACQUIRE, "agent"); } while (0)
template <int l>
__device__ __forceinline__ void gla_scan(LAS unsigned char* lds, unsigned char* ws, const float* w_lr, const float* b_lr, const int seq, const int wave, const int lane_in, const bool ctx_out) {
    const int b = seq >> 3, h = (seq >> 1) & 3, dir = seq & 1;
    LAS unsigned char* W = lds + wave * WAVE_LDS;
    const bf16* P = (const bf16*)(ws + WS_P); const float* GT = (const float*)(ws + WS_G); bf16* OG = (bf16*)(ws + WS_OG);
    const int r = lane_in & 15, g = lane_in >> 4;
    bf16x8v wfrag[2]; float bias[2][4];
#pragma unroll
    for (int dt = 0; dt < 2; ++dt) { float t[8];
#pragma unroll
        for (int j = 0; j < 8; ++j) t[j] = g < 2 ? w_lr[((size_t)(l * 2 + dir) * 16 + 8 * g + j) * 128 + h * 32 + 16 * dt + r] : 0.f;
        wfrag[dt] = pack8(t);
#pragma unroll
        for (int rg = 0; rg < 4; ++rg) bias[dt][rg] = b_lr[(l * 2 + dir) * 128 + h * 32 + 16 * dt + 4 * g + rg]; }
    const pg8::f32x4 zero4 = {0.f, 0.f, 0.f, 0.f};
    pg8::f32x4 Sown = zero4;
    for (int round = 0; round < 5; ++round) {
        int lane = lane_in; asm volatile("" : "+v"(lane));
        const int r = lane & 15, g = lane >> 4, q4 = r >> 2, p4 = lane & 3;
        const int n = round * 8 + wave; const bool active = n < 36;
        int rowbase = 0;
        if (n < 4) rowbase = MX + b * TC + (dir ? 3 - n : n) * 64; else rowbase = b * T + (dir ? 35 - n : n - 4) * 64;
        const int rsgn = dir ? -1 : 1, roff = dir ? rowbase + 63 : rowbase;
        bf16x8v Qf[4], Vf[4][2], K2f[2][2]; pg8::f32x4 O[4][4];
        if (active) {
#pragma unroll
            for (int it = 0; it < 8; ++it) { const int sp = it * 8 + (lane >> 3);
                const v4u x = *(const v4u*)(P + (size_t)(roff + rsgn * sp) * NP + PC_GV + h * 64 + (lane & 7) * 8);
                *(LAS v4u*)(W + GL_V + sp * 144 + (lane & 7) * 16) = x; }
            v2u qp[4][2], kp[4][2]; float la[4][8];
#pragma unroll
            for (int i = 0; i < 4; ++i) { const size_t tok = (size_t)(roff + rsgn * (16 * i + r));
                qp[i][0] = *(const v2u*)(P + tok * NP + PC_GQ + h * 32 + 4 * g); qp[i][1] = *(const v2u*)(P + tok * NP + PC_GQ + h * 32 + 16 + 4 * g);
                kp[i][0] = *(const v2u*)(P + tok * NP + PC_GK + h * 32 + 4 * g); kp[i][1] = *(const v2u*)(P + tok * NP + PC_GK + h * 32 + 16 + 4 * g);
                float lr[8];
                if (g < 2) { const f32x4 a0 = *(const f32x4*)(GT + tok * NG + dir * 16 + 8 * g), a1 = *(const f32x4*)(GT + tok * NG + dir * 16 + 8 * g + 4);
                    lr[0] = a0.x; lr[1] = a0.y; lr[2] = a0.z; lr[3] = a0.w; lr[4] = a1.x; lr[5] = a1.y; lr[6] = a1.z; lr[7] = a1.w; }
                else {
#pragma unroll
                    for (int j = 0; j < 8; ++j) lr[j] = 0.f; }
                const bf16x8v lrf = pack8(lr);
#pragma unroll
                for (int dt = 0; dt < 2; ++dt) { const pg8::f32x4 z = MFMA16(wfrag[dt], lrf, zero4);
#pragma unroll
                    for (int rg = 0; rg < 4; ++rg) { const float zz = z[rg] + bias[dt][rg]; la[i][dt * 4 + rg] = (fminf(zz, 0.f) * LOG2E - lg2(1.f + ex2(-fabsf(zz) * LOG2E))) * (1.f / 16.f); } } }
            float cl[8];
#pragma unroll
            for (int j = 0; j < 8; ++j) { float carry = 0.f;
#pragma unroll
                for (int i = 0; i < 4; ++i) { const float x = row_scan_add(la[i][j]) + carry; la[i][j] = x; carry = row_bcast15(x); }
                cl[j] = carry; }
            bf16x8v Kf[4]; float ecl[8];
#pragma unroll
            for (int j = 0; j < 8; ++j) ecl[j] = ex2(cl[j]);
#pragma unroll
            for (int i = 0; i < 4; ++i) { float tq[8], tk[8], t2[8];
                const float qv[8] = {bflo(qp[i][0].x), bfhi(qp[i][0].x), bflo(qp[i][0].y), bfhi(qp[i][0].y), bflo(qp[i][1].x), bfhi(qp[i][1].x), bflo(qp[i][1].y), bfhi(qp[i][1].y)};
                const float kv[8] = {bflo(kp[i][0].x), bfhi(kp[i][0].x), bflo(kp[i][0].y), bfhi(kp[i][0].y), bflo(kp[i][1].x), bfhi(kp[i][1].x), bflo(kp[i][1].y), bfhi(kp[i][1].y)};
#pragma unroll
                for (int j = 0; j < 8; ++j) { const float e1 = ex2(la[i][j]), kinv = kv[j] * __builtin_amdgcn_rcpf(e1); tq[j] = qv[j] * 0.17677669529663687f * e1; tk[j] = kinv; t2[j] = kinv * ecl[j]; }
                Qf[i] = pack8(tq); Kf[i] = pack8(tk);
                *(LAS bf16x8v*)(W + GL_K2 + (16 * i + r) * 80 + 16 * g) = pack8(t2); }
            if (r == 0) {
#pragma unroll
                for (int j = 0; j < 8; ++j) ((LAS float*)(W + GL_MISC))[8 * g + j] = ecl[j]; }
#pragma unroll
            for (int dt = 0; dt < 4; ++dt)
#pragma unroll
                for (int ks = 0; ks < 2; ++ks) { LAS unsigned char* a = W + GL_V + (32 * ks + 8 * g + q4) * 144 + (16 * dt + 4 * p4) * 2; Vf[dt][ks] = cat4(tr_read(a), tr_read(a + 4 * 144)); }
#pragma unroll
            for (int dd = 0; dd < 2; ++dd)
#pragma unroll
                for (int ks = 0; ks < 2; ++ks) { LAS unsigned char* a = W + GL_K2 + (32 * ks + 8 * g + q4) * 80 + (16 * dd + 4 * p4) * 2; K2f[dd][ks] = cat4(tr_read(a), tr_read(a + 4 * 80)); }
#pragma unroll
            for (int li = 0; li < 4; ++li) {
#pragma unroll
                for (int si = 0; si < 4; ++si) { pg8::f32x4 dd4 = zero4;
                    if (si <= li) { dd4 = MFMA16(Kf[si], Qf[li], zero4);
                        if (si == li) {
#pragma unroll
                            for (int rg = 0; rg < 4; ++rg) dd4[rg] = (r >= 4 * g + rg) ? dd4[rg] : 0.f; } }
                    v2u w; w.x = pg8::cvt_pk_safe(dd4[0], dd4[1]); w.y = pg8::cvt_pk_safe(dd4[2], dd4[3]);
                    *(LAS v2u*)(W + GL_SC + r * 144 + (16 * si + 4 * g) * 2) = w; }
#pragma unroll
                for (int ks = 0; ks < 2; ++ks) { const bf16x8v scf = *(const LAS bf16x8v*)(W + GL_SC + r * 144 + (32 * ks + 8 * g) * 2);
#pragma unroll
                    for (int dt = 0; dt < 4; ++dt) O[dt][li] = MFMA16(Vf[dt][ks], scf, ks == 0 ? zero4 : O[dt][li]); }
            }
        }
        __syncthreads();
        if (active) {
#pragma unroll
            for (int dd = 0; dd < 2; ++dd)
#pragma unroll
                for (int dt = 0; dt < 4; ++dt) { pg8::f32x4 U = MFMA16(K2f[dd][0], Vf[dt][0], zero4); U = MFMA16(K2f[dd][1], Vf[dt][1], U);
                    *(LAS pg8::f32x4*)(lds + (dd * 4 + dt) * WAVE_LDS + GL_V + wave * 1024 + lane * 16) = U; }
        }
        __syncthreads();
        {
            const int odd = wave >> 2, odt = wave & 3;
            pg8::f32x4 Uj[8], Dj[8];
#pragma unroll
            for (int j = 0; j < 8; ++j) { Uj[j] = *(const LAS pg8::f32x4*)(W + GL_V + j * 1024 + lane * 16); Dj[j] = *(const LAS pg8::f32x4*)(lds + j * WAVE_LDS + GL_MISC + (16 * odd + 4 * g) * 4); }
#pragma unroll
            for (int j = 0; j < 8; ++j) if (round * 8 + j < 36) {
                v2u w; w.x = pg8::cvt_pk_safe(Sown[0], Sown[1]); w.y = pg8::cvt_pk_safe(Sown[2], Sown[3]);
                *(LAS v2u*)(lds + j * WAVE_LDS + GL_K2 + (16 * odt + r) * 80 + (16 * odd + 4 * g) * 2) = w;
                Sown = Dj[j] * Sown + Uj[j]; }
        }
        __syncthreads();
        if (active) {
#pragma unroll
            for (int dt = 0; dt < 4; ++dt) { const bf16x8v stf = *(const LAS bf16x8v*)(W + GL_K2 + (16 * dt + r) * 80 + 16 * g);
#pragma unroll
                for (int li = 0; li < 4; ++li) O[dt][li] = MFMA16(stf, Qf[li], O[dt][li]); }
            if (n >= 4 || ctx_out) {
#pragma unroll
                for (int li = 0; li < 4; ++li) { bf16* orow = OG + ((size_t)dir * MT + (size_t)(roff + rsgn * (16 * li + r))) * 256 + h * 64 + 4 * g;
#pragma unroll
                    for (int dt = 0; dt < 4; ++dt) { v2u w; w.x = pg8::cvt_pk_safe(O[dt][li][0], O[dt][li][1]); w.y = pg8::cvt_pk_safe(O[dt][li][2], O[dt][li][3]); *(v2u*)(orow + 16 * dt) = w; } } }
        }
    }
}


constexpr int ML_V = 0, ML_KW = 8192, ML_SC = 16384, ML_B = 18688, ML_PM = 18944, ML_CUM = 19200, ML_DMX = 19456, ML_N = 19712;
constexpr int SCRM_SLOT = 4224, SCRM_SEQ = 9 * SCRM_SLOT * 4;
template <int l>
__device__ __forceinline__ void mlstm_scan(LAS unsigned char* lds, unsigned char* ws, const float* gate_b, const int seq, const int wave, const int lane_in, const bool ctx_out) {
    const int b = seq >> 3, h = (seq >> 1) & 3, dir = seq & 1;
    LAS unsigned char* W = lds + wave * WAVE_LDS;
    const bf16* P = (const bf16*)(ws + WS_P); const bf16* QK = (const bf16*)(ws + WS_QK); const float* GT = (const float*)(ws + WS_G); bf16* OM = (bf16*)(ws + WS_OM);
    const float gbi = gate_b[((l * 2 + dir) * 2 + 0) * 4 + h], gbf = gate_b[((l * 2 + dir) * 2 + 1) * 4 + h];
    const pg8::f32x4 zero4 = {0.f, 0.f, 0.f, 0.f};
    const bf16x8v ones = {16256, 16256, 16256, 16256, 16256, 16256, 16256, 16256};
    pg8::f32x4 Cown[2] = {zero4, zero4}, nown = zero4; float mst = 0.f;
    for (int round = 0; round < 5; ++round) {
        int lane = lane_in; asm volatile("" : "+v"(lane));
        const int r = lane & 15, g = lane >> 4, q4 = r >> 2, p4 = lane & 3;
        const int n = round * 8 + wave; const bool active = n < 36;
        int rowbase = 0;
        if (n < 4) rowbase = MX + b * TC + (dir ? 3 - n : n) * 64; else rowbase = b * T + (dir ? 35 - n : n - 4) * 64;
        const int rsgn = dir ? -1 : 1, roff = dir ? rowbase + 63 : rowbase;
        bf16x8v qf[4][2], Vf[4][2], kwf[4][2]; pg8::f32x4 O[4][4]; float dl[4] = {0.f, 0.f, 0.f, 0.f}; float fl_own = 0.f, mc_own = 0.f;
        if (active) {
#pragma unroll
            for (int it = 0; it < 8; ++it) { const int sp = it * 8 + (lane >> 3);
                const v4u x = *(const v4u*)(P + (size_t)(roff + rsgn * sp) * NP + PC_MV + h * 64 + (lane & 7) * 8);
                *(LAS v4u*)(W + ML_V + sp * 128 + (lane & 7) * 16) = x; }
            float wk;
            { const size_t rt = (size_t)(roff + rsgn * lane);
              const float ip = (GT[rt * NG + 32 + dir * 8 + h] + gbi) * LOG2E, fp = GT[rt * NG + 32 + dir * 8 + 4 + h] + gbf;
              const float lf = fminf(fp, 0.f) * LOG2E - lg2(1.f + ex2(-fabsf(fp) * LOG2E));
              float x = row_scan_add(lf); const float t0 = lane_bcast(x, 15), t1 = lane_bcast(x, 31), t2 = lane_bcast(x, 47);
              const float cum = x + (g >= 1 ? t0 : 0.f) + (g >= 2 ? t1 : 0.f) + (g >= 3 ? t2 : 0.f);
              const float cl = lane_bcast(cum, 63);
              const float bb = ip - cum;
              float y = row_scan_max(bb); const float m0 = lane_bcast(y, 15), m1 = lane_bcast(y, 31), m2 = lane_bcast(y, 47);
              float cm = -3.0e38f; if (g >= 1) cm = m0; if (g >= 2) cm = fmaxf(cm, m1); if (g >= 3) cm = fmaxf(cm, m2);
              const float pm = fmaxf(y, cm), pm63 = lane_bcast(pm, 63);
              mc_own = cl + pm63; fl_own = cl; wk = ex2(bb - pm63) * 0.125f;
              ((LAS float*)(W + ML_B))[lane] = bb; ((LAS float*)(W + ML_PM))[lane] = pm; ((LAS float*)(W + ML_CUM))[lane] = cum; ((LAS float*)(W + ML_DMX))[lane] = cum + pm; }
            bf16x8v kf[4][2];
#pragma unroll
            for (int i = 0; i < 4; ++i) { const size_t tok = (size_t)(roff + rsgn * (16 * i + r)); const float wki = __shfl(wk, 16 * i + r);
#pragma unroll
                for (int ks = 0; ks < 2; ++ks) { qf[i][ks] = *(const bf16x8v*)(QK + tok * 512 + h * 64 + 32 * ks + 8 * g); kf[i][ks] = *(const bf16x8v*)(QK + tok * 512 + 256 + h * 64 + 32 * ks + 8 * g);
                    const v4u kw4 = __builtin_bit_cast(v4u, kf[i][ks]);
                    float t[8] = {bflo(kw4.x) * wki, bfhi(kw4.x) * wki, bflo(kw4.y) * wki, bfhi(kw4.y) * wki, bflo(kw4.z) * wki, bfhi(kw4.z) * wki, bflo(kw4.w) * wki, bfhi(kw4.w) * wki};
                    *(LAS bf16x8v*)(W + ML_KW + (16 * i + r) * 128 + (32 * ks + 8 * g) * 2) = pack8(t); } }
#pragma unroll
            for (int dt = 0; dt < 4; ++dt)
#pragma unroll
                for (int ks = 0; ks < 2; ++ks) { LAS unsigned char* a = W + ML_V + (32 * ks + 8 * g + q4) * 128 + (16 * dt + 4 * p4) * 2; Vf[dt][ks] = cat4(tr_read(a), tr_read(a + 4 * 128)); }
#pragma unroll
            for (int li = 0; li < 4; ++li) { const float pml = ((const LAS float*)(W + ML_PM))[16 * li + r];
#pragma unroll
                for (int si = 0; si < 4; ++si) { pg8::f32x4 x4 = zero4;
                    if (si <= li) { x4 = MFMA16(kf[si][0], qf[li][0], zero4); x4 = MFMA16(kf[si][1], qf[li][1], x4);
                        const pg8::f32x4 bs = *(const LAS pg8::f32x4*)(W + ML_B + (16 * si + 4 * g) * 4);
#pragma unroll
                        for (int rg = 0; rg < 4; ++rg) { const float v = ex2(bs[rg] - pml) * x4[rg] * 0.125f; x4[rg] = (si < li || r >= 4 * g + rg) ? v : 0.f; } }
                    v2u w; w.x = pg8::cvt_pk_safe(x4[0], x4[1]); w.y = pg8::cvt_pk_safe(x4[2], x4[3]);
                    *(LAS v2u*)(W + ML_SC + r * 144 + (16 * si + 4 * g) * 2) = w; }
                pg8::f32x4 DLt = zero4;
#pragma unroll
                for (int ks = 0; ks < 2; ++ks) { const bf16x8v scf = *(const LAS bf16x8v*)(W + ML_SC + r * 144 + (32 * ks + 8 * g) * 2);
#pragma unroll
                    for (int dt = 0; dt < 4; ++dt) O[dt][li] = MFMA16(Vf[dt][ks], scf, ks == 0 ? zero4 : O[dt][li]);
                    DLt = MFMA16(ones, scf, DLt); }
                dl[li] = DLt[0];
            }
#pragma unroll
            for (int dd = 0; dd < 4; ++dd)
#pragma unroll
                for (int ks = 0; ks < 2; ++ks) { LAS unsigned char* a = W + ML_KW + (32 * ks + 8 * g + q4) * 128 + (16 * dd + 4 * p4) * 2; kwf[dd][ks] = cat4(tr_read(a), tr_read(a + 4 * 128)); }
        }
        __syncthreads();
        if (active) {
#pragma unroll
            for (int dd = 0; dd < 4; ++dd) { pg8::f32x4 Un = MFMA16(kwf[dd][0], ones, zero4); Un = MFMA16(kwf[dd][1], ones, Un);
#pragma unroll
                for (int dt = 0; dt < 4; ++dt) { pg8::f32x4 U = MFMA16(kwf[dd][0], Vf[dt][0], zero4); U = MFMA16(kwf[dd][1], Vf[dt][1], U);
                    v2u w; w.x = pg8::cvt_pk_safe(U[0], U[1]); w.y = pg8::cvt_pk_safe(U[2], U[3]);
                    *(LAS v2u*)(lds + (2 * dd + (dt >> 1)) * WAVE_LDS + ML_V + ((dt & 1) * 8 + wave) * 512 + lane * 8) = w; }
                if (r == 0) *(LAS pg8::f32x4*)(W + ML_B + (16 * dd + 4 * g) * 4) = Un; }
            if (lane == 0) { ((LAS float*)(W + ML_PM))[0] = mc_own; ((LAS float*)(W + ML_PM))[1] = fl_own; }
        }
        __syncthreads();
        float m = 0.f;
        {
            const int odd = wave >> 1, odt = 2 * (wave & 1);
#pragma unroll
            for (int j = 0; j < 8; ++j) if (round * 8 + j < 36) {
                LAS unsigned char* Wj = lds + j * WAVE_LDS;
                const float mcj = ((const LAS float*)(Wj + ML_PM))[0], flj = ((const LAS float*)(Wj + ML_PM))[1];
                const v2u u0 = *(const LAS v2u*)(W + ML_V + j * 512 + lane * 8), u1 = *(const LAS v2u*)(W + ML_V + (8 + j) * 512 + lane * 8);
                const pg8::f32x4 Nj = wave < 4 ? *(const LAS pg8::f32x4*)(Wj + ML_B + (16 * wave + 4 * g) * 4) : zero4;
#pragma unroll
                for (int t = 0; t < 2; ++t) { v2u w; w.x = pg8::cvt_pk_safe(Cown[t][0], Cown[t][1]); w.y = pg8::cvt_pk_safe(Cown[t][2], Cown[t][3]);
                    *(LAS v2u*)(Wj + ML_KW + (16 * (odt + t) + r) * 128 + (16 * odd + 4 * g) * 2) = w; }
                if (wave < 4 && r == 0) { v2u w; w.x = pg8::cvt_pk_safe(nown[0], nown[1]); w.y = pg8::cvt_pk_safe(nown[2], nown[3]); *(LAS v2u*)(Wj + ML_N + (16 * wave + 4 * g) * 2) = w; }
                if (j == wave) m = mst;
                const float mn = fmaxf(flj + mst, mcj), a = ex2(flj + mst - mn), gs = ex2(mcj - mn);
                Cown[0] = Cown[0] * a + (pg8::f32x4){bflo(u0.x), bfhi(u0.x), bflo(u0.y), bfhi(u0.y)} * gs; Cown[1] = Cown[1] * a + (pg8::f32x4){bflo(u1.x), bfhi(u1.x), bflo(u1.y), bfhi(u1.y)} * gs; nown = nown * a + Nj * gs; mst = mn; }
        }
        __syncthreads();
        if (active) {
            bf16x8v nf[2];
#pragma unroll
            for (int ks = 0; ks < 2; ++ks) nf[ks] = *(const LAS bf16x8v*)(W + ML_N + (32 * ks + 8 * g) * 2);
            const bool do_store = (n >= 4 || ctx_out);
#pragma unroll
            for (int li = 0; li < 4; ++li) {
                const float pl = ((const LAS float*)(W + ML_CUM))[16 * li + r] + m, dmx = ((const LAS float*)(W + ML_DMX))[16 * li + r];
                const float mrow = fmaxf(pl, dmx), f1 = ex2(dmx - mrow), f2 = ex2(pl - mrow), cv = ex2(-mrow);
                pg8::f32x4 DI = MFMA16(nf[0], qf[li][0], zero4); DI = MFMA16(nf[1], qf[li][1], DI);
                const float den = f1 * dl[li] + f2 * DI[0];
                const float inv = 1.f / fmaxf(fabsf(den), cv);
                bf16* orow = OM + ((size_t)dir * MT + (size_t)(roff + rsgn * (16 * li + r))) * 256 + h * 64 + 4 * g;
#pragma unroll
                for (int dt = 0; dt < 4; ++dt) {
                    const bf16x8v c0 = *(const LAS bf16x8v*)(W + ML_KW + (16 * dt + r) * 128 + (8 * g) * 2), c1 = *(const LAS bf16x8v*)(W + ML_KW + (16 * dt + r) * 128 + (32 + 8 * g) * 2);
                    pg8::f32x4 Tt = MFMA16(c0, qf[li][0], zero4); Tt = MFMA16(c1, qf[li][1], Tt);
                    const pg8::f32x4 o = (O[dt][li] * f1 + Tt * f2) * inv;
                    if (do_store) { v2u w; w.x = pg8::cvt_pk_safe(o[0], o[1]); w.y = pg8::cvt_pk_safe(o[2], o[3]); *(v2u*)(orow + 16 * dt) = w; } }
            }
        }
    }
}


constexpr int SG_STRIDE = 544;
__device__ __forceinline__ void sgu_unit(LAS unsigned char* lds, unsigned char* ws, const bf16* WSG, const float* sb, const int row0, const int tid, const int wave, const int lane) {
    const bf16* P = (const bf16*)(ws + WS_P); bf16* HM = (bf16*)(ws + WS_HM);
    {
        const int sp = tid >> 2, qd = tid & 3; const bf16* src = P + (size_t)(row0 + sp) * NP + PC_SV + 64 * qd;
        v4u x[8]; float sum = 0.f;
#pragma unroll
        for (int i = 0; i < 8; ++i) { x[i] = *(const v4u*)(src + 8 * i); sum += (bflo(x[i].x) + bfhi(x[i].x)) + (bflo(x[i].y) + bfhi(x[i].y)) + (bflo(x[i].z) + bfhi(x[i].z)) + (bflo(x[i].w) + bfhi(x[i].w)); }
        sum = quad_sum4(sum);
        const float mu = sum * (1.f / 256.f); float sq = 0.f;
#pragma unroll
        for (int i = 0; i < 8; ++i) { const unsigned ww[4] = {x[i].x, x[i].y, x[i].z, x[i].w};
#pragma unroll
            for (int q = 0; q < 4; ++q) { const float a = bflo(ww[q]) - mu, c = bfhi(ww[q]) - mu; sq += a * a + c * c; } }
        sq = quad_sum4(sq);
        const float rstd = rsqrtf(sq * (1.f / 256.f) + EPS);
#pragma unroll
        for (int i = 0; i < 8; ++i) { const unsigned ww[4] = {x[i].x, x[i].y, x[i].z, x[i].w}; v4u o;
            o.x = pk2((bflo(ww[0]) - mu) * rstd, (bfhi(ww[0]) - mu) * rstd); o.y = pk2((bflo(ww[1]) - mu) * rstd, (bfhi(ww[1]) - mu) * rstd);
            o.z = pk2((bflo(ww[2]) - mu) * rstd, (bfhi(ww[2]) - mu) * rstd); o.w = pk2((bflo(ww[3]) - mu) * rstd, (bfhi(ww[3]) - mu) * rstd);
            *(LAS v4u*)(lds + sp * SG_STRIDE + (64 * qd + 8 * i) * 2) = o; }
    }
    __syncthreads();
    {
        const int r = lane & 15, g = lane >> 4, q4 = r >> 2, p4 = lane & 3, gg = wave >> 1, mh = wave & 1;
        pg8::f32x4 acc[4][4];
#pragma unroll
        for (int ct = 0; ct < 4; ++ct)
#pragma unroll
            for (int lt = 0; lt < 4; ++lt) acc[ct][lt] = (pg8::f32x4){0.f, 0.f, 0.f, 0.f};
#pragma unroll
        for (int ks = 0; ks < 4; ++ks) { bf16x8v Af[4], Bf[4];
#pragma unroll
            for (int ct = 0; ct < 4; ++ct) { LAS unsigned char* a = lds + (32 * ks + 8 * g + q4) * SG_STRIDE + (gg * 64 + 16 * ct + 4 * p4) * 2; Af[ct] = cat4(tr_read(a), tr_read(a + 4 * SG_STRIDE)); }
#pragma unroll
            for (int lt = 0; lt < 4; ++lt) Bf[lt] = *(const bf16x8v*)(WSG + ((size_t)gg * 128 + 64 * mh + 16 * lt + r) * 128 + 32 * ks + 8 * g);
#pragma unroll
            for (int ct = 0; ct < 4; ++ct)
#pragma unroll
                for (int lt = 0; lt < 4; ++lt) acc[ct][lt] = MFMA16(Af[ct], Bf[lt], acc[ct][lt]); }
#pragma unroll
        for (int lt = 0; lt < 4; ++lt) { const int lpos = 64 * mh + 16 * lt + r; const size_t row = (size_t)(row0 + lpos); const float bias = sb[gg * 128 + lpos];
#pragma unroll
            for (int ct = 0; ct < 4; ++ct) { const int c = gg * 64 + 16 * ct + 4 * g; const v2u uu = *(const v2u*)(P + row * NP + PC_SU + c);
                v2u w; w.x = pg8::cvt_pk_safe(bflo(uu.x) * (acc[ct][lt][0] + bias), bfhi(uu.x) * (acc[ct][lt][1] + bias)); w.y = pg8::cvt_pk_safe(bflo(uu.y) * (acc[ct][lt][2] + bias), bfhi(uu.y) * (acc[ct][lt][3] + bias));
                *(v2u*)(HM + row * D + 512 + c) = w; } }
    }
    __syncthreads();
}

template <bool BASEF32> struct EpiRes16 {
    static constexpr bool PERM = true;
    const void* xbase; bf16* xout; const void* cbase; bf16* cout; const float* modl; int goff;
    __device__ __forceinline__ void operator()(const pg8::f32x4 (&acc)[2][2][4][2], const pg8::Unit& u, int wr, int wc, int fr, int fq) const {
        const void* basep; bf16* outp; int bidx; size_t rb;
        if (u.pm < 64) { bidx = u.pm >> 3; rb = (size_t)u.pm * 256; basep = xbase; outp = xout; } else { bidx = 8; rb = (size_t)(u.pm - 64) * 256; basep = cbase; outp = cout; }
        const float* gatep = modl + bidx * 6144 + goff;
        const int col0 = u.pn * 256 + wc * 32 + 8 * fq, r0 = wr * 64 + fr;
        pg8::f32x4 gv[2][2];
#pragma unroll
        for (int bj = 0; bj < 2; ++bj)
#pragma unroll
            for (int n = 0; n < 2; ++n) gv[bj][n] = *(const pg8::f32x4*)(gatep + col0 + bj * 128 + 4 * n);
#pragma unroll
        for (int ai = 0; ai < 2; ++ai)
#pragma unroll
            for (int m = 0; m < 4; ++m) { const size_t off = (rb + r0 + ai * 128 + m * 16) * D + col0;
#pragma unroll
                for (int bj = 0; bj < 2; ++bj) { pg8::f32x4 b0, b1;
                    if (BASEF32) { b0 = __builtin_nontemporal_load((const pg8::f32x4*)((const float*)basep + off + bj * 128)); b1 = __builtin_nontemporal_load((const pg8::f32x4*)((const float*)basep + off + bj * 128 + 4)); }
                    else { const pg8::u32x4 bw = *(const pg8::u32x4*)((const bf16*)basep + off + bj * 128);
                        b0 = (pg8::f32x4){bflo(bw.x), bfhi(bw.x), bflo(bw.y), bfhi(bw.y)}; b1 = (pg8::f32x4){bflo(bw.z), bfhi(bw.z), bflo(bw.w), bfhi(bw.w)}; }
                    const pg8::f32x4 v0 = b0 + gv[bj][0] * acc[ai][bj][m][0], v1 = b1 + gv[bj][1] * acc[ai][bj][m][1];
                    pg8::u32x4 w; w.x = pg8::cvt_pk_bf16(v0[0], v0[1]); w.y = pg8::cvt_pk_bf16(v0[2], v0[3]); w.z = pg8::cvt_pk_bf16(v1[0], v1[1]); w.w = pg8::cvt_pk_bf16(v1[2], v1[3]);
                    *(pg8::u32x4*)(outp + off + bj * 128) = w; } }
    }
};

struct Args { const float* in[25]; float* out; unsigned char* ws; int ph_lo, ph_hi, submask, pad; };

__device__ __forceinline__ void transpose_block(const float* W, int ldw, bf16* dst, int K, LAS float* scr, int lane) {
    f32x4 v[8];
#pragma unroll
    for (int i = 0; i < 8; ++i) v[i] = __builtin_nontemporal_load((const f32x4*)(W + (size_t)(8 * i + (lane >> 3)) * ldw + 4 * (lane & 7)));
#pragma unroll
    for (int i = 0; i < 8; ++i) { LAS float* p = scr + (8 * i + (lane >> 3)) * 33 + 4 * (lane & 7); p[0] = v[i].x; p[1] = v[i].y; p[2] = v[i].z; p[3] = v[i].w; }
    LDS_WAIT(); asm volatile("" ::: "memory");
    const int c = lane & 7;
#pragma unroll
    for (int j = 0; j < 4; ++j) { const int n = (lane >> 3) + 8 * j; const LAS float* s = scr + (8 * c) * 33 + n;
        v4u o; o.x = pk2(s[0 * 33], s[1 * 33]); o.y = pk2(s[2 * 33], s[3 * 33]); o.z = pk2(s[4 * 33], s[5 * 33]); o.w = pk2(s[6 * 33], s[7 * 33]);
        __builtin_nontemporal_store(o, (v4u*)(dst + (size_t)n * K + 8 * c)); }
    LDS_WAIT(); asm volatile("" ::: "memory");
}


constexpr int MOE_I_MGU = 16 * 224, MOE_I_MD = 56 * 32, MOE_ITEMS = 8 * MOE_I_MGU + 8 * MOE_I_MD;
__device__ __forceinline__ void moe_convert_range(const int lo, const int hi, const int widx, const int nw, const float* wg, const float* wu, const float* wd, unsigned char* ws, LAS float* scr, const int lane) {
    for (int it = lo + widx; it < hi; it += nw) { int r = it;
        if (r < 8 * MOE_I_MGU) { const int e = r / MOE_I_MGU; r -= e * MOE_I_MGU; const int kb = r / 224, nb = r % 224, r0 = 32 * nb, tile = r0 >> 8, half = (r0 >> 7) & 1, j = r0 & 127;
            const float* src = (half ? wu : wg) + (size_t)e * D * DFE + (size_t)(64 * kb) * DFE + 128 * tile + j;
            transpose_block(src, DFE, (bf16*)(ws + WS_WTMGU) + (size_t)e * 2 * DFE * D + (size_t)r0 * D + 64 * kb, D, scr, lane); }
        else { r -= 8 * MOE_I_MGU; const int e = r / MOE_I_MD; r -= e * MOE_I_MD; const int kb = r / 32, nb = r % 32;
            transpose_block(wd + (size_t)e * DFE * D + (size_t)(64 * kb) * D + 32 * nb, D, (bf16*)(ws + WS_WTMD) + (size_t)e * D * DFE + (size_t)(32 * nb) * DFE + 64 * kb, DFE, scr, lane); } }
}

#define AS4 __attribute__((address_space(4)))
typedef const AS4 unsigned char* kptr_t;
__device__ __forceinline__ kptr_t kargs() { kptr_t p = (kptr_t)__builtin_amdgcn_kernarg_segment_ptr(); asm volatile("" : "+s"(p)); return p; }
#define KIN(i) (*(const float* const AS4*)(ka + 8 * (i)))
#define KOUT   (*(float* const AS4*)(ka + 200))
#define KWS    (*(unsigned char* const AS4*)(ka + 208))
#define KLO    (*(const int AS4*)(ka + 216))
#define KHI    (*(const int AS4*)(ka + 220))
#define KSUB   (*(const int AS4*)(ka + 224))
#define PH_BEGIN(k) PH_BEGIN_T(k, 31)
#define PH_BEGIN_T(k, tag) { const kptr_t ka = kargs(); if (KLO <= (k) && (k) < KHI && ((KSUB >> (tag)) & 1)) { unsigned char* const ws = KWS; (void)ws; \
    int tid = threadIdx.x; asm volatile("" : "+v"(tid)); const int lane = tid & 63, wave = __builtin_amdgcn_readfirstlane(tid >> 6), G = gridDim.x, bx = blockIdx.x; \
    const int gw = bx * NWAVES + wave, NGW = G * NWAVES, gtid = bx * (NWAVES * 64) + tid, NGT = G * NWAVES * 64; (void)lane; (void)gw; (void)NGW; (void)gtid; (void)NGT;
#define PH_END } }
#define SEAM(k) { if (MK_ONE_LAUNCH) { const kptr_t ka = kargs(); if (KLO <= (k) && (k) + 1 < KHI) xcd_barrier(bar); } }
#define WSP(T, off) ((T*)(ws + (off)))

template <int l>
__device__ __forceinline__ void layer_phases(LAS unsigned char* lds, const XcdBarrier& bar) {
        const int pb = 1 + l * 16;
        const bool ctx_out = (l == 0);
        PH_BEGIN(pb + 0)
            const float* modl = WSP(float, WS_MOD) + (size_t)l * 9 * 6144;
            const float* ng = KIN(6) + l * D;
            bf16* HM = WSP(bf16, WS_HM);
            for (int row = gw; row < MT; row += NGW) {
                const float* mrow = modl + (row < MX ? (row >> 11) : 8) * 6144;
                f32x4 v[4]; float ss = 0.f;
                if (l == 0) { const float* src = row < MX ? KIN(0) + (size_t)row * D : KIN(2) + (size_t)(row - MX) * D;
#pragma unroll
                    for (int j = 0; j < 4; ++j) v[j] = __builtin_nontemporal_load((const f32x4*)(src + 4 * lane + 256 * j)); }
                else if (row < MX) { const bf16* src = WSP(bf16, WS_XS16) + (size_t)row * D;
#pragma unroll
                    for (int j = 0; j < 4; ++j) { const v2u w = *(const v2u*)(src + 4 * lane + 256 * j); v[j] = (f32x4){bflo(w.x), bfhi(w.x), bflo(w.y), bfhi(w.y)}; } }
                else { const size_t rc = (size_t)(row - MX); const bf16* src = WSP(bf16, WS_XC) + rc * D; const bf16* p0 = WSP(bf16, WS_CPART) + rc * D; const bf16* p1 = p0 + (size_t)MC * D; const float* g2p = WSP(float, WS_MOD) + 8 * 6144 + 5120;
#pragma unroll
                    for (int j = 0; j < 4; ++j) { const int c = 4 * lane + 256 * j; const v2u w = *(const v2u*)(src + c), a = *(const v2u*)(p0 + c), b2 = *(const v2u*)(p1 + c); const f32x4 g2 = *(const f32x4*)(g2p + c);
                        v[j] = (f32x4){bflo(w.x) + g2.x * (bflo(a.x) + bflo(b2.x)), bfhi(w.x) + g2.y * (bfhi(a.x) + bfhi(b2.x)), bflo(w.y) + g2.z * (bflo(a.y) + bflo(b2.y)), bfhi(w.y) + g2.w * (bfhi(a.y) + bfhi(b2.y))}; } }
#pragma unroll
                for (int j = 0; j < 4; ++j) ss += (v[j].x * v[j].x + v[j].y * v[j].y) + (v[j].z * v[j].z + v[j].w * v[j].w);
                const float rstd = rsqrtf(wave_sum(ss) * (1.f / D) + EPS);
#pragma unroll
                for (int j = 0; j < 4; ++j) { const int c = 4 * lane + 256 * j; const f32x4 g = *(const f32x4*)(ng + c), sh = *(const f32x4*)(mrow + c), sc = *(const f32x4*)(mrow + 1024 + c);
                    v[j] = v[j] * rstd * g * (sc + 1.f) + sh;
                    v2u o; o.x = pk2(v[j].x, v[j].y); o.y = pk2(v[j].z, v[j].w); *(v2u*)(HM + (size_t)row * D + c) = o; }
            }
        PH_END
        SEAM(pb + 0)
        PH_BEGIN(pb + 1)
            InProjSched S; S.init(WSP(bf16, WS_HM), WSP(bf16, WS_WTIN) + (size_t)l * NPG * D, l == 0 ? 11 : 8, G, bx);
            EpiInProj E{WSP(bf16, WS_P), WSP(float, WS_G)};
            pg8::gemm_phase<EpiInProj, InProjSched, PG8_ALIGN, PG8_SP2>(lds, D, S, E);
        PH_END
        PH_BEGIN(pb + 1)
            if (l == 0 && bx >= 24) moe_convert_range(12000, 14000, (bx - 24) * 8 + wave, 232 * 8, KIN(21), KIN(22), KIN(23), ws, (LAS float*)(lds + wave * 16384), lane);
        PH_END
        SEAM(pb + 1)
        PH_BEGIN(pb + 2)
            const bf16* P = WSP(bf16, WS_P); bf16* QK = WSP(bf16, WS_QK);
            const float* cw = KIN(13) + l * 9 * 512;
            f32x4 w0[9], w1[9];
            { const int ch = (gtid & 63) * 8;
#pragma unroll
              for (int tp = 0; tp < 9; ++tp) { w0[tp] = *(const f32x4*)(cw + tp * 512 + ch); w1[tp] = *(const f32x4*)(cw + tp * 512 + ch + 4); } }
            for (int i = gtid; i < MT * 64; i += NGT) {
                const int row = i >> 6, ch = (i & 63) * 8;
                int base, rr0, cc0, nr, nc;
                if (row < MX) { base = (row >> 11) * T; const int t = row & 2047; rr0 = t >> 6; cc0 = t & 63; nr = 32; nc = 64; }
                else { const int rc = row - MX; base = MX + (rc >> 8) * TC; rr0 = 0; cc0 = rc & 255; nr = 1; nc = 256; }
                v4u x[9];
#pragma unroll
                for (int dr = -1; dr <= 1; ++dr)
#pragma unroll
                    for (int dc = -1; dc <= 1; ++dc) { const int rr = rr0 + dr, cc = cc0 + dc; const bool ok = (unsigned)rr < (unsigned)nr && (unsigned)cc < (unsigned)nc;
                        const v4u xv = *(const v4u*)(P + (size_t)(base + (ok ? rr : rr0) * nc + (ok ? cc : cc0)) * NP + PC_MQ + ch);
                        x[(dr + 1) * 3 + (dc + 1)] = ok ? xv : (v4u){0u, 0u, 0u, 0u}; }
                float y[8];
#pragma unroll
                for (int j = 0; j < 8; ++j) y[j] = 0.f;
#pragma unroll
                for (int tp = 0; tp < 9; ++tp) { y[0] += bflo(x[tp].x) * w0[tp].x; y[1] += bfhi(x[tp].x) * w0[tp].y; y[2] += bflo(x[tp].y) * w0[tp].z; y[3] += bfhi(x[tp].y) * w0[tp].w;
                    y[4] += bflo(x[tp].z) * w1[tp].x; y[5] += bfhi(x[tp].z) * w1[tp].y; y[6] += bflo(x[tp].w) * w1[tp].z; y[7] += bfhi(x[tp].w) * w1[tp].w; }
                v4u o; o.x = pk2(siluf_(y[0]), siluf_(y[1])); o.y = pk2(siluf_(y[2]), siluf_(y[3])); o.z = pk2(siluf_(y[4]), siluf_(y[5])); o.w = pk2(siluf_(y[6]), siluf_(y[7]));
                *(v4u*)(QK + (size_t)row * 512 + ch) = o;
            }
        PH_END
        PH_BEGIN(pb + 2)
            const bf16* P = WSP(bf16, WS_P); const bf16* TWCH = WSP(bf16, WS_TWCH);
            const int r = lane & 15, g = lane >> 4; LAS unsigned char* W = lds + wave * WAVE_LDS;
            const int nitems = ctx_out ? (MT / 64) * 4 : (MX / 64) * 4;
            for (int it = gw; it < nitems; it += NGW) {
                const int blk = it >> 2, gg = it & 3, row0 = blk * 64;
                bf16* fb; int Tn, t0;
                if (row0 < MX) { const int b = row0 >> 11; t0 = row0 & 2047; Tn = T; fb = WSP(bf16, WS_FBX) + ((size_t)b * 256 + gg * 64) * 4096; }
                else { const int rc = row0 - MX, b = rc >> 8; t0 = rc & 255; Tn = TC; fb = WSP(bf16, WS_FBC) + ((size_t)b * 256 + gg * 64) * 512; }
                bf16x8v Af[4][2];
#pragma unroll
                for (int i = 0; i < 4; ++i)
#pragma unroll
                    for (int ks = 0; ks < 2; ++ks) Af[i][ks] = *(const bf16x8v*)(P + (size_t)(row0 + 16 * i + r) * NP + PC_F + gg * 64 + 32 * ks + 8 * g);
#pragma unroll
                for (int nt = 0; nt < 8; ++nt) { const bf16x8v b0 = *(const bf16x8v*)(TWCH + (16 * nt + r) * 64 + 8 * g), b1 = *(const bf16x8v*)(TWCH + (16 * nt + r) * 64 + 32 + 8 * g);
#pragma unroll
                    for (int i = 0; i < 4; ++i) { pg8::f32x4 d = MFMA16(Af[i][0], b0, ((pg8::f32x4){0.f, 0.f, 0.f, 0.f})); d = MFMA16(Af[i][1], b1, d);
                        v2u w; w.x = pg8::cvt_pk_safe(d[0], d[1]); w.y = pg8::cvt_pk_safe(d[2], d[3]); *(LAS v2u*)(W + (16 * nt + r) * 144 + (16 * i + 4 * g) * 2) = w; } }
#pragma unroll
                for (int j = 0; j < 16; ++j) { const int np = j * 8 + (lane >> 3); const v4u x = *(const LAS v4u*)(W + np * 144 + (lane & 7) * 16);
                    *(v4u*)(fb + (size_t)(np & 63) * (2 * Tn) + (np >= 64 ? Tn : 0) + t0 + (lane & 7) * 8) = x; }
            }
        PH_END
        SEAM(pb + 2)
        PH_BEGIN_T(pb + 3, 0)
            if (bx < 64) gla_scan<l>(lds, ws, KIN(10), KIN(11), bx, wave, lane, ctx_out);
        PH_END
        PH_BEGIN_T(pb + 3, 1)
            if (bx >= 64 && bx < 128) mlstm_scan<l>(lds, ws, KIN(14), bx - 64, wave, lane, ctx_out);
        PH_END
        PH_BEGIN_T(pb + 3, 2)
            if (bx >= 192) {
                const bf16* WSG = WSP(bf16, WS_WSGU) + (size_t)l * 4 * 128 * 128; const float* sb = KIN(16) + l * 4 * 128;
                const int nunits = ctx_out ? 144 : 128;
                for (int u = bx - 192; u < nunits; u += 64) sgu_unit(lds, ws, WSG, sb, u < 128 ? u * 128 : MX + (u - 128) * 128, tid, wave, lane);
            }
        PH_END
        PH_BEGIN_T(pb + 3, 3)
            BatchSched S{(const char*)WSP(bf16, WS_TWX), (const char*)WSP(bf16, WS_FBX), (size_t)256 * 4096 * 2, (size_t)256 * 4096 * 2, (size_t)2048 * 2, 128, 8, G, bx - 128};
            EpiFourier E{WSP(bf16, WS_HM) + 768, D, (size_t)T * D, WSP(bf16, WS_MIXB), 256, (size_t)T * 256};
            pg8::gemm_phase<EpiFourier, BatchSched, PG8_ALIGN, PG8_SP2>(lds, 2048, S, E, 4096);
        PH_END
        if (ctx_out) {
        PH_BEGIN_T(pb + 3, 4)
            BatchSched S{(const char*)WSP(bf16, WS_TWC), (const char*)WSP(bf16, WS_FBC), (size_t)256 * 512 * 2, (size_t)256 * 512 * 2, (size_t)256 * 2, 16, 1, G, bx - 128};
            EpiFourier E{WSP(bf16, WS_HM) + (size_t)MX * D + 768, D, (size_t)TC * D, WSP(bf16, WS_MIXB) + (size_t)MX * 256, 256, (size_t)TC * 256};
            pg8::gemm_phase<EpiFourier, BatchSched, PG8_ALIGN, PG8_SP2>(lds, 256, S, E, 512);
        PH_END
        }
        PH_BEGIN(pb + 3)
            if (bx >= 192) moe_convert_range(l == 0 ? 0 : 4000, l == 0 ? 4000 : 8000, (bx - 192) * 8 + wave, 64 * 8, KIN(21), KIN(22), KIN(23), ws, (LAS float*)(lds + wave * 16384), lane);
            if (bx >= 128 && bx < 192) moe_convert_range(l == 0 ? 8000 : 39000, l == 0 ? 12000 : MOE_ITEMS, (bx - 128) * 8 + wave, 64 * 8, KIN(21), KIN(22), KIN(23), ws, (LAS float*)(lds + wave * 16384), lane);
        PH_END
        SEAM(pb + 3)
        PH_BEGIN(pb + 4)
            const bf16* P = WSP(bf16, WS_P); const bf16* OG = WSP(bf16, WS_OG); const bf16* OM = WSP(bf16, WS_OM); bf16* HM = WSP(bf16, WS_HM); const bf16* MIXB = WSP(bf16, WS_MIXB);
            const float* gng = KIN(12) + l * 256;
            constexpr int NB = (l == 0) ? 3 : 4, NIT = (l == 0) ? 3 : 2;
            const int c = 4 * lane; const f32x4 ng = *(const f32x4*)(gng + c);
            for (int it = 0; it < NIT; ++it) {
                v2u of[NB], ob[NB], gg[NB], hf[NB], hb[NB], og[NB], fa[NB], fb[NB];
#pragma unroll
                for (int k = 0; k < NB; ++k) { const size_t row = (size_t)(gw + (it * NB + k) * NGW);
                    of[k] = __builtin_nontemporal_load((const v2u*)(OG + row * 256 + c)); ob[k] = __builtin_nontemporal_load((const v2u*)(OG + ((size_t)MT + row) * 256 + c));
                    hf[k] = __builtin_nontemporal_load((const v2u*)(OM + row * 256 + c)); hb[k] = __builtin_nontemporal_load((const v2u*)(OM + ((size_t)MT + row) * 256 + c));
                    gg[k] = *(const v2u*)(P + row * NP + PC_GG + c); og[k] = *(const v2u*)(P + row * NP + PC_MO + c);
                    fa[k] = *(const v2u*)(HM + row * D + 768 + c); fb[k] = __builtin_nontemporal_load((const v2u*)(MIXB + row * 256 + c)); }
#pragma unroll
                for (int k = 0; k < NB; ++k) { const size_t row = (size_t)(gw + (it * NB + k) * NGW);
                    const float o0 = bflo(of[k].x) + bflo(ob[k].x), o1 = bfhi(of[k].x) + bfhi(ob[k].x), o2 = bflo(of[k].y) + bflo(ob[k].y), o3 = bfhi(of[k].y) + bfhi(ob[k].y);
                    float ss = (o0 * o0 + o1 * o1) + (o2 * o2 + o3 * o3);
                    ss = row_sum16(ss);
                    const float rs = rsqrtf(ss * (1.f / 64.f) + EPS);
                    v2u w; w.x = pk2(o0 * rs * ng.x * siluf_(bflo(gg[k].x)), o1 * rs * ng.y * siluf_(bfhi(gg[k].x))); w.y = pk2(o2 * rs * ng.z * siluf_(bflo(gg[k].y)), o3 * rs * ng.w * siluf_(bfhi(gg[k].y)));
                    *(v2u*)(HM + row * D + c) = w;
                    v2u w2; w2.x = pk2(sigmoidf_(bflo(og[k].x)) * (bflo(hf[k].x) + bflo(hb[k].x)), sigmoidf_(bfhi(og[k].x)) * (bfhi(hf[k].x) + bfhi(hb[k].x)));
                    w2.y = pk2(sigmoidf_(bflo(og[k].y)) * (bflo(hf[k].y) + bflo(hb[k].y)), sigmoidf_(bfhi(og[k].y)) * (bfhi(hf[k].y) + bfhi(hb[k].y)));
                    *(v2u*)(HM + row * D + 256 + c) = w2;
                    v2u w3; w3.x = pk2(bflo(fa[k].x) + bflo(fb[k].x), bfhi(fa[k].x) + bfhi(fb[k].x)); w3.y = pk2(bflo(fa[k].y) + bflo(fb[k].y), bfhi(fa[k].y) + bfhi(fb[k].y)); *(v2u*)(HM + row * D + 768 + c) = w3; }
            }
        PH_END
        SEAM(pb + 4)
        PH_BEGIN(pb + 5)
            DenseSched S; S.init(WSP(bf16, WS_HM), WSP(bf16, WS_WTOUT) + (size_t)l * D * D, MX / 256, D / 256, D, G, bx);
            if (l == 0) { EpiRes16<true> E{KIN(0), WSP(bf16, WS_XS16), KIN(2), WSP(bf16, WS_XC), WSP(float, WS_MOD), 2048};
                pg8::gemm_phase<EpiRes16<true>, DenseSched, PG8_ALIGN, PG8_SP2>(lds, D, S, E);
                CtxSplitSched S2{(const char*)(WSP(bf16, WS_HM) + (size_t)MX * D), (const char*)WSP(bf16, WS_WTOUT), (size_t)256 * D * 2, (size_t)512 * 2, G, (bx + 128) & 255};
                EpiKSplit E2{WSP(bf16, WS_CPART), (size_t)MC * D};
                pg8::gemm_phase<EpiKSplit, CtxSplitSched, PG8_ALIGN, PG8_SP2>(lds, 512, S2, E2, D); }
            else { EpiRes16<false> E{WSP(bf16, WS_XS16), WSP(bf16, WS_XS16), WSP(bf16, WS_XC), WSP(bf16, WS_XC), WSP(float, WS_MOD) + (size_t)9 * 6144, 2048};
                pg8::gemm_phase<EpiRes16<false>, DenseSched, PG8_ALIGN, PG8_SP2>(lds, D, S, E); }
        PH_END
        PH_BEGIN(pb + 5)
            if (false) moe_convert_range(0, 0, 0, 1, KIN(21), KIN(22), KIN(23), ws, (LAS float*)(lds + wave * 16384), lane);
        PH_END
        SEAM(pb + 5)
        PH_BEGIN(pb + 6)
            const bf16* xs = WSP(bf16, WS_XS16); const bf16* XC = WSP(bf16, WS_XC); const float* modl = WSP(float, WS_MOD) + (size_t)l * 9 * 6144; bf16* HM = WSP(bf16, WS_HM);
            const float* ng = KIN(7) + l * D; const float* moe_router = KIN(20);
            float* RG = WSP(float, WS_ROUTE + 65536); int* RE = WSP(int, WS_ROUTE); int* RP = WSP(int, WS_ROUTE + 65536 * 3);
            LAS int* lcnt = (LAS int*)lds; LAS int* wgb = lcnt + 8; LAS int* rinfo = lcnt + 16;
            if (l == 1) { if (tid < 16) lcnt[tid] = 0; __syncthreads(); }
            const int nrows = ctx_out ? MT : MX, rpw = nrows / NGW;
            for (int ri = 0; ri < rpw; ++ri) {
                const int row = gw + ri * NGW;
                const float* mrow = modl + (row < MX ? (row >> 11) : 8) * 6144;
                f32x4 v[4]; float ss = 0.f;
                if (row < MX) { const bf16* src = xs + (size_t)row * D;
#pragma unroll
                    for (int j = 0; j < 4; ++j) { const v2u w = *(const v2u*)(src + 4 * lane + 256 * j); v[j] = (f32x4){bflo(w.x), bfhi(w.x), bflo(w.y), bfhi(w.y)}; } }
                else { const size_t rc = (size_t)(row - MX); const float* cin = KIN(2) + rc * D; const bf16* p0 = WSP(bf16, WS_CPART) + rc * D; const bf16* p1 = p0 + (size_t)MC * D; bf16* xcw = WSP(bf16, WS_XC) + rc * D;
#pragma unroll
                    for (int j = 0; j < 4; ++j) { const int c = 4 * lane + 256 * j; const v2u a = *(const v2u*)(p0 + c), b2 = *(const v2u*)(p1 + c); const f32x4 g1 = *(const f32x4*)(mrow + 2048 + c), ci = *(const f32x4*)(cin + c);
                        const f32x4 pp = {bflo(a.x) + bflo(b2.x), bfhi(a.x) + bfhi(b2.x), bflo(a.y) + bflo(b2.y), bfhi(a.y) + bfhi(b2.y)};
                        v2u o; o.x = pk2(ci.x + g1.x * pp.x, ci.y + g1.y * pp.y); o.y = pk2(ci.z + g1.z * pp.z, ci.w + g1.w * pp.w); *(v2u*)(xcw + c) = o;
                        v[j] = (f32x4){bflo(o.x), bfhi(o.x), bflo(o.y), bfhi(o.y)}; } }
#pragma unroll
                for (int j = 0; j < 4; ++j) ss += (v[j].x * v[j].x + v[j].y * v[j].y) + (v[j].z * v[j].z + v[j].w * v[j].w);
                const float rstd = rsqrtf(wave_sum(ss) * (1.f / D) + EPS);
#pragma unroll
                for (int j = 0; j < 4; ++j) { const int c = 4 * lane + 256 * j; const f32x4 g = *(const f32x4*)(ng + c), sh = *(const f32x4*)(mrow + 3072 + c), sc = *(const f32x4*)(mrow + 4096 + c);
                    v[j] = v[j] * rstd * g * (sc + 1.f) + sh;
                    v2u o; o.x = pk2(v[j].x, v[j].y); o.y = pk2(v[j].z, v[j].w); *(v2u*)(HM + (size_t)row * D + c) = o; }
                if (l == 1) {
                    float lg[8];
#pragma unroll
                    for (int e = 0; e < 8; ++e) lg[e] = 0.f;
#pragma unroll
                    for (int j = 0; j < 4; ++j) { const float vv[4] = {v[j].x, v[j].y, v[j].z, v[j].w};
#pragma unroll
                        for (int q = 0; q < 4; ++q) { const float* wr_ = moe_router + (size_t)(4 * lane + 256 * j + q) * 8; const f32x4 w0 = *(const f32x4*)wr_, w1 = *(const f32x4*)(wr_ + 4);
                            lg[0] += vv[q] * w0.x; lg[1] += vv[q] * w0.y; lg[2] += vv[q] * w0.z; lg[3] += vv[q] * w0.w; lg[4] += vv[q] * w1.x; lg[5] += vv[q] * w1.y; lg[6] += vv[q] * w1.z; lg[7] += vv[q] * w1.w; } }
#pragma unroll
                    for (int e = 0; e < 8; ++e) lg[e] = wave_sum(lg[e]);
                    float v0 = lg[0]; int e0 = 0;
#pragma unroll
                    for (int e = 1; e < 8; ++e) if (lg[e] > v0) { v0 = lg[e]; e0 = e; }
                    float v1 = -3.0e38f; int e1 = 0;
#pragma unroll
                    for (int e = 0; e < 8; ++e) if (e != e0 && lg[e] > v1) { v1 = lg[e]; e1 = e; }
                    if (lane == 0) { const float g0 = 1.f / (1.f + __expf(v1 - v0));
                        RG[row * 2] = g0; RG[row * 2 + 1] = 1.f - g0;
                        const int lp0 = __hip_atomic_fetch_add(&lcnt[e0], 1, __ATOMIC_RELAXED, __HIP_MEMORY_SCOPE_WORKGROUP);
                        const int lp1 = __hip_atomic_fetch_add(&lcnt[e1], 1, __ATOMIC_RELAXED, __HIP_MEMORY_SCOPE_WORKGROUP);
                        const int lr = wave * rpw + ri; rinfo[lr * 4] = e0; rinfo[lr * 4 + 1] = e1; rinfo[lr * 4 + 2] = lp0; rinfo[lr * 4 + 3] = lp1; }
                }
            }
            if (l == 1) {
                __syncthreads();
                if (tid < 8) wgb[tid] = (int)__hip_atomic_fetch_add((unsigned*)(ws + WS_CTL) + CW_CNT + tid * 64, (unsigned)lcnt[tid], RLX_AGENT);
                __syncthreads();
                if (tid < 64) { const int row = bx * 8 + (tid >> 3) + (tid & 7) * NGW; const int e0 = rinfo[tid * 4], e1 = rinfo[tid * 4 + 1];
                    RE[row] = e0 | (e1 << 8); RP[row * 2] = wgb[e0] + rinfo[tid * 4 + 2]; RP[row * 2 + 1] = wgb[e1] + rinfo[tid * 4 + 3]; }
                __syncthreads();
            }
        PH_END
        SEAM(pb + 6)
        if (l == 0) {
            PH_BEGIN(pb + 7)
                DenseSched S; S.init(WSP(bf16, WS_HM), WSP(bf16, WS_WTGU), MT / 256, 2 * DFF / 256, D, G, bx);
                EpiSwiGLU E{WSP(bf16, WS_ACTF), DFF};
                pg8::gemm_phase<EpiSwiGLU, DenseSched, PG8_ALIGN, PG8_SP2>(lds, D, S, E);
            PH_END
            PH_BEGIN(pb + 7)
                if (bx >= 48) moe_convert_range(14000, 24000, (bx - 48) * 8 + wave, 208 * 8, KIN(21), KIN(22), KIN(23), ws, (LAS float*)(lds + wave * 16384), lane);
            PH_END
            SEAM(pb + 7)
            PH_BEGIN(pb + 8)
                DenseSched S; S.init(WSP(bf16, WS_ACTF), WSP(bf16, WS_WTD), MX / 256, D / 256, DFF, G, bx);
                EpiRes16<false> E{WSP(bf16, WS_XS16), WSP(bf16, WS_XS16), WSP(bf16, WS_XC), WSP(bf16, WS_XC), WSP(float, WS_MOD), 5120};
                pg8::gemm_phase<EpiRes16<false>, DenseSched, PG8_ALIGN, PG8_SP2>(lds, DFF, S, E);
                CtxSplitSched S2{(const char*)(WSP(bf16, WS_ACTF) + (size_t)MX * DFF), (const char*)WSP(bf16, WS_WTD), (size_t)256 * DFF * 2, (size_t)1408 * 2, G, (bx + 128) & 255};
                EpiKSplit E2{WSP(bf16, WS_CPART), (size_t)MC * D};
                pg8::gemm_phase<EpiKSplit, CtxSplitSched, PG8_ALIGN, PG8_SP2>(lds, 1408, S2, E2, DFF);
            PH_END
            PH_BEGIN(pb + 8)
                if (bx < 128 || bx >= 192) moe_convert_range(24000, 39000, (bx < 128 ? bx : bx - 64) * 8 + wave, 192 * 8, KIN(21), KIN(22), KIN(23), ws, (LAS float*)(lds + wave * 16384), lane);
            PH_END
            SEAM(pb + 8)
        } else {
            PH_BEGIN(pb + 7)
                const bf16* HM = WSP(bf16, WS_HM); bf16* XS = WSP(bf16, WS_XS); const int* RE = WSP(int, WS_ROUTE); const int* RP = WSP(int, WS_ROUTE + 65536 * 3); int* RS = WSP(int, WS_ROUTE + 65536 * 5);
                int tbA[8];
                { int a0 = 0;
#pragma unroll
                  for (int e = 0; e < 8; ++e) { tbA[e] = a0; a0 += ((int)__builtin_amdgcn_readfirstlane(__hip_atomic_load((unsigned*)(ws + WS_CTL) + CW_CNT + e * 64, RLX_AGENT)) + 255) >> 8; } }
                for (int it = 0; it < 2; ++it) {
                    int ee[4], rp0[4], rp1[4]; v4u a[4], b2[4];
#pragma unroll
                    for (int k = 0; k < 4; ++k) { const int row = gw + (it * 4 + k) * NGW; ee[k] = RE[row]; rp0[k] = RP[row * 2]; rp1[k] = RP[row * 2 + 1];
                        a[k] = __builtin_nontemporal_load((const v4u*)(HM + (size_t)row * D + 8 * lane)); b2[k] = __builtin_nontemporal_load((const v4u*)(HM + (size_t)row * D + 512 + 8 * lane)); }
#pragma unroll
                    for (int k = 0; k < 4; ++k) { const int row = gw + (it * 4 + k) * NGW; const int e0 = ee[k] & 255, e1 = ee[k] >> 8;
                        int tb0 = 0, tb1 = 0;
#pragma unroll
                        for (int e = 0; e < 8; ++e) { tb0 = (e == e0) ? tbA[e] : tb0; tb1 = (e == e1) ? tbA[e] : tb1; }
                        const int s0 = tb0 * 256 + rp0[k], s1 = tb1 * 256 + rp1[k];
                        *(v4u*)(XS + (size_t)s0 * D + 8 * lane) = a[k]; *(v4u*)(XS + (size_t)s0 * D + 512 + 8 * lane) = b2[k];
                        *(v4u*)(XS + (size_t)s1 * D + 8 * lane) = a[k]; *(v4u*)(XS + (size_t)s1 * D + 512 + 8 * lane) = b2[k];
                        if (lane == 0) { RS[row * 2] = s0; RS[row * 2 + 1] = s1; } }
                }
            PH_END
            SEAM(pb + 7)
#pragma unroll
            for (int ps = 0; ps < 2; ++ps) {
                PH_BEGIN(pb + 8 + 2 * ps)
                    MoeSched S; S.W = (const char*)(ws + WS_WTMGU); S.tstepA = (size_t)256 * D * 2; S.tstepW = (size_t)256 * D * 2; S.estride = (size_t)2 * DFE * D * 2;
                    { int a0 = 0;
#pragma unroll
                      for (int e = 0; e < 8; ++e) { S.tb[e] = a0; a0 += ((int)__builtin_amdgcn_readfirstlane(__hip_atomic_load((unsigned*)(ws + WS_CTL) + CW_CNT + e * 64, RLX_AGENT)) + 255) >> 8; }
                      S.tb[8] = a0; }
                    S.t0 = MOE_PASS * ps; int nt = S.tb[8] - S.t0; if (ps == 0) nt = nt > MOE_PASS ? MOE_PASS : nt;
                    if (nt > 0) {
                        S.A = (const char*)(ws + WS_XS) + (size_t)S.t0 * S.tstepA; S.o.init(nt, 2 * DFE / 256, G, bx);
                        EpiSwiGLU E{WSP(bf16, WS_ACTM), DFE};
                        pg8::gemm_phase<EpiSwiGLU, MoeSched, PG8_ALIGN, PG8_SP2>(lds, D, S, E);
                    }
                PH_END
                SEAM(pb + 8 + 2 * ps)
                PH_BEGIN(pb + 9 + 2 * ps)
                    MoeSched S; S.A = (const char*)(ws + WS_ACTM); S.W = (const char*)(ws + WS_WTMD); S.tstepA = (size_t)256 * DFE * 2; S.tstepW = (size_t)256 * DFE * 2; S.estride = (size_t)D * DFE * 2;
                    { int a0 = 0;
#pragma unroll
                      for (int e = 0; e < 8; ++e) { S.tb[e] = a0; a0 += ((int)__builtin_amdgcn_readfirstlane(__hip_atomic_load((unsigned*)(ws + WS_CTL) + CW_CNT + e * 64, RLX_AGENT)) + 255) >> 8; }
                      S.tb[8] = a0; }
                    S.t0 = MOE_PASS * ps; int nt = S.tb[8] - S.t0; nt = nt > MOE_PASS ? MOE_PASS : nt;
                    if (nt > 0) {
                        S.o.init(nt, D / 256, G, bx);
                        EpiBf16Plain E{WSP(bf16, WS_XS) + (size_t)S.t0 * 256 * D, D, 0};
                        pg8::gemm_phase<EpiBf16Plain, MoeSched, PG8_ALIGN, PG8_SP2>(lds, DFE, S, E);
                    }
                PH_END
                if (ps == 1) {
                PH_BEGIN(pb + 9 + 2 * ps)
                    KSplitSched S; S.A = (const char*)(ws + WS_ACTM) + (size_t)64 * 256 * DFE * 2; S.W = (const char*)(ws + WS_WTMD); S.tstepA = (size_t)256 * DFE * 2; S.tstepW = (size_t)256 * DFE * 2; S.estride = (size_t)D * DFE * 2;
                    { int a0 = 0;
#pragma unroll
                      for (int e = 0; e < 8; ++e) { S.tb[e] = a0; a0 += ((int)__builtin_amdgcn_readfirstlane(__hip_atomic_load((unsigned*)(ws + WS_CTL) + CW_CNT + e * 64, RLX_AGENT)) + 255) >> 8; }
                      S.tb[8] = a0; }
                    const int nleft = S.tb[8] - 128;
                    if (nleft > 0) {
                        S.nunits = nleft * 16; S.G = G; S.c = (bx + 128) & 255;
                        EpiKSplit E{WSP(bf16, WS_YLP), (size_t)8 * 256 * D};
                        pg8::gemm_phase<EpiKSplit, KSplitSched, PG8_ALIGN, PG8_SP2>(lds, 896, S, E, DFE);
                    }
                PH_END
                }
                SEAM(pb + 9 + 2 * ps)
            }
            PH_BEGIN(pb + 14)
                float* xs = KOUT; const bf16* XS16 = WSP(bf16, WS_XS16); const float* modl = WSP(float, WS_MOD) + (size_t)9 * 6144; const float* final_norm_g = KIN(24);
                const int* RS = WSP(int, WS_ROUTE + 65536 * 5); const float* RG = WSP(float, WS_ROUTE + 65536); const bf16* Yh = WSP(bf16, WS_XS); const bf16* YLP = WSP(bf16, WS_YLP);
                for (int it = 0; it < 4; ++it) {
                    int s0[2], s1[2]; float g0[2], g1[2];
#pragma unroll
                    for (int k = 0; k < 2; ++k) { const int row = gw + (it * 2 + k) * NGW; s0[k] = RS[row * 2]; s1[k] = RS[row * 2 + 1]; g0[k] = RG[row * 2]; g1[k] = RG[row * 2 + 1]; }
                    v2u y0[2][4], y1[2][4], xw[2][4];
#pragma unroll
                    for (int k = 0; k < 2; ++k) { const int row = gw + (it * 2 + k) * NGW; const int c0 = s0[k] < 128 * 256 ? s0[k] : 0, c1 = s1[k] < 128 * 256 ? s1[k] : 0;
#pragma unroll
                        for (int j = 0; j < 4; ++j) { const int c = 4 * lane + 256 * j;
                            y0[k][j] = __builtin_nontemporal_load((const v2u*)(Yh + (size_t)c0 * D + c)); y1[k][j] = __builtin_nontemporal_load((const v2u*)(Yh + (size_t)c1 * D + c));
                            xw[k][j] = __builtin_nontemporal_load((const v2u*)(XS16 + (size_t)row * D + c)); } }
#pragma unroll
                    for (int k = 0; k < 2; ++k) { const int row = gw + (it * 2 + k) * NGW;
                        const float* mrow = modl + (row >> 11) * 6144 + 5120;
                        f32x4 v[4]; float ss = 0.f;
#pragma unroll
                        for (int j = 0; j < 4; ++j) { const int c = 4 * lane + 256 * j;
                            f32x4 ya = {bflo(y0[k][j].x), bfhi(y0[k][j].x), bflo(y0[k][j].y), bfhi(y0[k][j].y)}, yb = {bflo(y1[k][j].x), bfhi(y1[k][j].x), bflo(y1[k][j].y), bfhi(y1[k][j].y)};
                            if (s0[k] >= 128 * 256) { ya = (f32x4){0.f, 0.f, 0.f, 0.f};
#pragma unroll
                                for (int k4 = 0; k4 < 4; ++k4) { const v2u t = *(const v2u*)(YLP + ((size_t)k4 * 2048 + (s0[k] - 128 * 256)) * D + c); ya += (f32x4){bflo(t.x), bfhi(t.x), bflo(t.y), bfhi(t.y)}; } }
                            if (s1[k] >= 128 * 256) { yb = (f32x4){0.f, 0.f, 0.f, 0.f};
#pragma unroll
                                for (int k4 = 0; k4 < 4; ++k4) { const v2u t = *(const v2u*)(YLP + ((size_t)k4 * 2048 + (s1[k] - 128 * 256)) * D + c); yb += (f32x4){bflo(t.x), bfhi(t.x), bflo(t.y), bfhi(t.y)}; } }
                            const f32x4 xv = {bflo(xw[k][j].x), bfhi(xw[k][j].x), bflo(xw[k][j].y), bfhi(xw[k][j].y)}, g2 = *(const f32x4*)(mrow + c);
                            const f32x4 y = ya * g0[k] + yb * g1[k];
                            v[j] = xv + g2 * y; ss += (v[j].x * v[j].x + v[j].y * v[j].y) + (v[j].z * v[j].z + v[j].w * v[j].w); }
                        const float rstd = rsqrtf(wave_sum(ss) * (1.f / D) + EPS);
#pragma unroll
                        for (int j = 0; j < 4; ++j) { const int c = 4 * lane + 256 * j; const f32x4 g = *(const f32x4*)(final_norm_g + c); __builtin_nontemporal_store(v[j] * rstd * g, (f32x4*)(xs + (size_t)row * D + c)); } }
                }
            PH_END
        }
    }

__global__ void __launch_bounds__(NWAVES * 64, 2) fwd(Args args_unused) {
    extern __shared__ __attribute__((aligned(16))) unsigned char lds_raw[];
    LAS unsigned char* lds = (LAS unsigned char*)lds_raw;
    for (int u = threadIdx.x; u < (LDS_BYTES - LDSCTL_OFF) / 4; u += NWAVES * 64) ((LAS unsigned*)(lds + LDSCTL_OFF))[u] = 0u;
    __syncthreads();
    XcdBarrier bar; bar.bar = nullptr; bar.x = 0; bar.st = nullptr;
    if (MK_ONE_LAUNCH) { const kptr_t ka = kargs(); bar = xcd_barrier_post((unsigned*)(KWS + WS_CTL) + CW_BAR, (volatile LAS unsigned*)(lds + MISC_OFF) + 8); }

    PH_BEGIN(0)
        LAS float* scr = (LAS float*)(lds + wave * 16384);
        const float* w_in = KIN(8); const float* w_out = KIN(9);
        constexpr int I_IN = 16 * 80, I_OUT = 16 * 32, I_GU = 16 * 176, I_D = 44 * 32;
        constexpr int NITEMS = 2 * I_IN + 2 * I_OUT + I_GU + I_D;
        for (int it = gw; it < NITEMS; it += NGW) {
            int r = it;
            if (r < 2 * I_IN) { const int l = r / I_IN; r -= l * I_IN; const int kb = r / 80, nb = r % 80; const int sc = 32 * nb + (nb >= 24 ? 32 : 0) + (nb >= 56 ? 16 : 0);
                transpose_block(w_in + (size_t)l * D * D_IN + (size_t)(64 * kb) * D_IN + sc, D_IN, WSP(bf16, WS_WTIN) + (size_t)l * NPG * D + (size_t)(32 * nb) * D + 64 * kb, D, scr, lane); continue; }
            r -= 2 * I_IN;
            if (r < 2 * I_OUT) { const int l = r / I_OUT; r -= l * I_OUT; const int kb = r / 32, nb = r % 32;
                transpose_block(w_out + (size_t)l * D * D + (size_t)(64 * kb) * D + 32 * nb, D, WSP(bf16, WS_WTOUT) + (size_t)l * D * D + (size_t)(32 * nb) * D + 64 * kb, D, scr, lane); continue; }
            r -= 2 * I_OUT;
            if (r < I_GU) { const int kb = r / 176, nb = r % 176, r0 = 32 * nb, tile = r0 >> 8, half = (r0 >> 7) & 1, j = r0 & 127;
                const float* src = (half ? KIN(18) : KIN(17)) + (size_t)(64 * kb) * DFF + 128 * tile + j;
                transpose_block(src, DFF, WSP(bf16, WS_WTGU) + (size_t)r0 * D + 64 * kb, D, scr, lane); continue; }
            r -= I_GU;
            if (r < I_D) { const int kb = r / 32, nb = r % 32;
                transpose_block(KIN(19) + (size_t)(64 * kb) * D + 32 * nb, D, WSP(bf16, WS_WTD) + (size_t)(32 * nb) * DFF + 64 * kb, DFF, scr, lane); continue; }
        }
        { bf16* WTIN = WSP(bf16, WS_WTIN);
          for (int i = gtid; i < 2 * 256 * D; i += NGT) { const int l = i / (256 * D), j = (i / D) & 255, k = i % D; const int oc = j < 32 ? 768 + j : 1824 + (j - 32);
            WTIN[(size_t)l * NPG * D + (size_t)(NP + j) * D + k] = j < NG ? (bf16)f2bf(w_in[(size_t)l * D * D_IN + (size_t)k * D_IN + oc]) : (bf16)0; }
          bf16* WSG = WSP(bf16, WS_WSGU); const float* sw = KIN(15);
          for (int i = gtid; i < 2 * 4 * 128 * 128; i += NGT) WSG[i] = (bf16)f2bf(sw[i]); }
        { bf16* TWX = WSP(bf16, WS_TWX); bf16* TWC = WSP(bf16, WS_TWC);
          for (int i = gtid; i < 2048 * 4096; i += NGT) { const int k = i >> 12, t = i & 4095, j = (k * (t & 2047)) & 2047; const float ang = (float)j * (6.283185307179586f / 2048.f);
            const float v = (t < 2048 ? __cosf(ang) : __sinf(ang)) * 0.0027621358640099515f; TWX[i] = (bf16)f2bf(v); }
          for (int i = gtid; i < 256 * 512; i += NGT) { const int k = i >> 9, t = i & 511, j = (k * (t & 255)) & 255; const float ang = (float)j * (6.283185307179586f / 256.f);
            const float v = (t < 256 ? __cosf(ang) : __sinf(ang)) * 0.0078125f; TWC[i] = (bf16)f2bf(v); } }
        { bf16* TWCH = WSP(bf16, WS_TWCH);
          for (int i = gtid; i < 128 * 64; i += NGT) { const int np = i >> 6, c = i & 63, m = np & 63; const float ang = (float)((m * c) & 63) * (6.283185307179586f / 64.f);
            TWCH[i] = (bf16)f2bf(np < 64 ? __cosf(ang) : -__sinf(ang)); } }
        __syncthreads();
        if (bx < 192) {
            const float* c_in = KIN(1); const float* cctx_in = KIN(3); const float* w_ada = KIN(4); const float* b_ada = KIN(5); float* MOD = WSP(float, WS_MOD);
            LAS float* sil = (LAS float*)lds; LAS float* red = (LAS float*)(lds + 36864);
            for (int i = tid; i < 9 * D; i += NWAVES * 64) { const int b = i >> 10, k = i & 1023; const float v = b < 8 ? c_in[b * D + k] : cctx_in[k]; sil[i] = siluf_(v); }
            __syncthreads();
            const int l = bx / 96, col = (bx % 96) * 64 + lane;
            const float* W = w_ada + (size_t)l * D * 6144 + col;
            float acc[9];
#pragma unroll
            for (int b = 0; b < 9; ++b) acc[b] = 0.f;
            for (int k0 = wave * 128; k0 < wave * 128 + 128; k0 += 16) { float w[16];
#pragma unroll
                for (int kk = 0; kk < 16; ++kk) w[kk] = __builtin_nontemporal_load(W + (size_t)(k0 + kk) * 6144);
#pragma unroll 4
                for (int kk = 0; kk < 16; ++kk)
#pragma unroll
                    for (int b = 0; b < 9; ++b) acc[b] += sil[b * D + k0 + kk] * w[kk]; }
#pragma unroll
            for (int b = 0; b < 9; ++b) red[(wave * 9 + b) * 64 + lane] = acc[b];
            __syncthreads();
            if (wave == 0) {
#pragma unroll
                for (int b = 0; b < 9; ++b) { float s = b_ada[l * 6144 + col];
#pragma unroll
                    for (int w = 0; w < 8; ++w) s += red[(w * 9 + b) * 64 + lane];
                    MOD[(size_t)(l * 9 + b) * 6144 + col] = s; } }
            __syncthreads();
        }
    PH_END
    SEAM(0)

    layer_phases<0>(lds, bar);
    layer_phases<1>(lds, bar);
}

extern "C" void kernel_launch(void* const* d_in, const int* in_sizes, int n_in, void* d_out, int out_size, void* d_ws, size_t ws_size, hipStream_t stream) {
    static int grid = 0;
    if (grid == 0) {
        if (n_in != 25 || out_size != MX * D || ws_size < WS_END) { fprintf(stderr, "kernel_launch: unexpected problem (n_in %d out %d ws %zu need %zu)\n", n_in, out_size, ws_size, (size_t)WS_END); grid = -1; return; }
        int dev = 0, cus = 0, per_cu = 0;
        if (hipGetDevice(&dev) != hipSuccess || hipDeviceGetAttribute(&cus, hipDeviceAttributeMultiprocessorCount, dev) != hipSuccess) { grid = -1; return; }
        if (hipFuncSetAttribute((const void*)fwd, hipFuncAttributeMaxDynamicSharedMemorySize, LDS_BYTES) != hipSuccess) { grid = -1; return; }
        if (hipOccupancyMaxActiveBlocksPerMultiprocessor(&per_cu, (const void*)fwd, NWAVES * 64, LDS_BYTES) != hipSuccess || per_cu < 1) { fprintf(stderr, "kernel_launch: occupancy query says %d\n", per_cu); }
        (void)hipGetLastError();
        grid = cus;
        if (grid != 256) { fprintf(stderr, "kernel_launch: built for 256 CUs, got %d\n", grid); grid = -1; return; }
    }
    if (grid < 0) return;
    if (hipMemsetAsync((char*)d_ws + WS_CTL, 0, CTL_ZERO_BYTES, stream) != hipSuccess) return;
    Args a{};
    for (int i = 0; i < 25; ++i) a.in[i] = (const float*)d_in[i];
    a.out = (float*)d_out; a.ws = (unsigned char*)d_ws;
    constexpr int NPH = 33;
    a.submask = -1; a.pad = 0;
#if MK_ONE_LAUNCH
    a.ph_lo = 0; a.ph_hi = NPH;
    hipLaunchKernelGGL(fwd, dim3(grid), dim3(NWAVES * 64), LDS_BYTES, stream, a);
#else
    for (int p = 0; p < NPH; ++p) {
        if (p >= 10 && p <= 16) continue;
        if (p >= 32) continue;
        a.ph_lo = p; a.ph_hi = p + 1; a.submask = -1;
        hipLaunchKernelGGL(fwd, dim3(grid), dim3(NWAVES * 64), LDS_BYTES, stream, a);
#ifdef PROBE_PH
        if (p == PROBE_PH) { a.submask = PROBE_SUBMASK; for (int k = 0; k < PROBE_REPS; ++k) hipLaunchKernelGGL(fwd, dim3(grid), dim3(NWAVES * 64), LDS_BYTES, stream, a); }
#endif
    }
#endif
}
```

```cpp
#include <hip/hip_runtime.h>
#include <cstdio>
#include <cstdint>

#ifndef MK_ONE_LAUNCH
#define MK_ONE_LAUNCH 1
#endif

namespace pg8 {
#define PG8_LAS __attribute__((address_space(3)))
typedef unsigned short bf16_t;
typedef short bf16x8 __attribute__((ext_vector_type(8)));
typedef float f32x4 __attribute__((ext_vector_type(4)));
typedef float f32x2 __attribute__((ext_vector_type(2)));
typedef unsigned u32x4 __attribute__((ext_vector_type(4)));
constexpr int BM = 256, BK = 64, HALF = 128, HTB = HALF * BK * 2, STAGE_BYTES = 8 * HTB, NXCD = 8, WGM = 8;

__host__ __device__ __forceinline__ int lds_byte(int r, int c) { const int st = (r >> 4) * 2 + (c >> 5), rr = r & 15, cc = c & 31, ob = rr * 64 + cc * 2; return st * 1024 + (ob ^ (((ob >> 9) & 1) << 5)); }
__host__ __device__ __forceinline__ void stage_rc(int b, int& R, int& C) { const int st = b / 1024, sb = b % 1024, swz = sb ^ (((sb >> 9) & 1) << 5); R = (st >> 1) * 16 + swz / 64; C = (st & 1) * 32 + (swz % 64) / 2; }
__host__ __device__ __forceinline__ int perm32(int rho) { const int n = rho >> 4, i = rho & 15; return 8 * (i >> 2) + 4 * n + (i & 3); }

struct Unit { int pm, pn, z; };

struct StaticOrder {
    int nM, nN, nwg, G, c;
    __host__ __device__ void init(int nM_, int nN_, int G_, int c_) { nM = nM_; nN = nN_; nwg = nM * nN; G = G_; c = c_; }
    __host__ __device__ bool next(int i, Unit& u) const {
        const long L = (long)i * G + c; if (L >= nwg) return false;
        int wgid = (int)L; { const int q = nwg / NXCD, r = nwg % NXCD, xcd = wgid % NXCD, off = wgid / NXCD; wgid = (xcd < r ? xcd * (q + 1) : r * (q + 1) + (xcd - r) * q) + off; }
        const int nig = WGM * nN, gid = wgid / nig, fm = gid * WGM, gsz = (nM - fm) < WGM ? (nM - fm) : WGM;
        u.pm = fm + ((wgid % nig) % gsz); u.pn = (wgid % nig) / gsz; u.z = 0; return true;
    }
};

typedef __bf16 bf16v2_t __attribute__((ext_vector_type(2)));
__device__ __forceinline__ unsigned cvt_pk_safe(float lo, float hi) { const bf16v2_t v = __builtin_convertvector((f32x2){lo, hi}, bf16v2_t); return __builtin_bit_cast(unsigned, v); }
__device__ __forceinline__ unsigned cvt_pk_bf16(float lo, float hi) { return cvt_pk_safe(lo, hi); }

template <class Epi, class Sched, bool ALIGN_EPI = false, bool SP2 = false, bool GATHER = false>
__device__ __forceinline__ void gemm_phase(PG8_LAS unsigned char* lds, const int K, const Sched& S, const Epi& E, const int pitch_ = 0) {
    const int tid = threadIdx.x, wid = __builtin_amdgcn_readfirstlane(tid >> 6), lane = tid & 63, wr = wid >> 2, wc = wid & 3, fr = lane & 15, fq = lane >> 4;
    const int nt = K / BK, pitch = pitch_ ? pitch_ : K;
    unsigned voffA[2], voffB[2];
#pragma unroll
    for (int i = 0; i < 2; ++i) { int R, C; stage_rc(tid * 16 + i * 8192, R, C); const int Rb = Epi::PERM ? ((R & ~31) + perm32(R & 31)) : R;
        voffA[i] = (unsigned)(R * pitch + C) * 2u; voffB[i] = (unsigned)(Rb * pitch + C) * 2u; }
    const size_t kstep = (size_t)(BK * 2);
    const size_t hstep = (size_t)HALF * pitch * 2;
    const unsigned ldsw = (unsigned)wid * 1024u;
    const int aoff = lds_byte(wr * 64 + fr, fq * 8), boff = lds_byte(wc * 32 + fr, fq * 8);
#define PG8_SA(b, h) (((b) * 2 + (h)) * HTB)
#define PG8_SB(b, h) ((4 + (b) * 2 + (h)) * HTB)
#define PG8_STAGE(bufoff, gbase, voff) do { _Pragma("unroll") for (int _i = 0; _i < 2; ++_i) \
        __builtin_amdgcn_global_load_lds((const unsigned*)((const char*)(gbase) + (voff)[_i]), (PG8_LAS unsigned*)(lds + (bufoff) + ldsw + _i * 8192), 16, 0, 0); } while (0)
#define PG8_STAGE_A(bufoff, ptr, h, nx) do { if constexpr (GATHER) { const unsigned _v[2] = {(nx) ? gS[h][0] : gC[h][0], (nx) ? gS[h][1] : gC[h][1]}; PG8_STAGE(bufoff, ptr, _v); } \
        else { PG8_STAGE(bufoff, (ptr) + (h) * hstep, voffA); } } while (0)
#define PG8_LDA(dst, b, h) do { _Pragma("unroll") for (int m = 0; m < 4; ++m) _Pragma("unroll") for (int k = 0; k < 2; ++k) dst[m][k] = *(const PG8_LAS bf16x8*)(lds + PG8_SA(b, h) + aoff + m * 2048 + k * 1024); } while (0)
#define PG8_LDB(dst, b, h) do { _Pragma("unroll") for (int n = 0; n < 2; ++n) _Pragma("unroll") for (int k = 0; k < 2; ++k) dst[n][k] = *(const PG8_LAS bf16x8*)(lds + PG8_SB(b, h) + boff + n * 2048 + k * 1024); } while (0)
#define PG8_MMA(ai, bj, At, Bt) do { __builtin_amdgcn_s_setprio(1); _Pragma("unroll") for (int m = 0; m < 4; ++m) _Pragma("unroll") for (int n = 0; n < 2; ++n) _Pragma("unroll") for (int k = 0; k < 2; ++k) \
        acc[ai][bj][m][n] = __builtin_amdgcn_mfma_f32_16x16x32_bf16(Bt[n][k], At[m][k], acc[ai][bj][m][n], 0, 0, 0); __builtin_amdgcn_s_setprio(0); } while (0)
#define PG8_WAIT_V(n) asm volatile("s_waitcnt vmcnt(" #n ")" ::: "memory")
#define PG8_WAIT_L(n) asm volatile("s_waitcnt lgkmcnt(" #n ")" ::: "memory")
#define PG8_BAR __builtin_amdgcn_s_barrier()
#define PG8_SCHED __builtin_amdgcn_sched_barrier(0)
    Unit cur, nxt; int ui = 0;
    if (!S.next(0, cur)) return;
    unsigned gC[2][2] = {{0u, 0u}, {0u, 0u}}, gN[2][2] = {{0u, 0u}, {0u, 0u}}, gS[2][2] = {{0u, 0u}, {0u, 0u}};
    int gR[2] = {0, 0}; unsigned gCb[2] = {0u, 0u};
    if constexpr (GATHER) {
#pragma unroll
        for (int i = 0; i < 2; ++i) { int R, C; stage_rc(tid * 16 + i * 8192, R, C); gR[i] = R; gCb[i] = (unsigned)C * 2u; }
#pragma unroll
        for (int h = 0; h < 2; ++h)
#pragma unroll
            for (int i = 0; i < 2; ++i) { gN[h][i] = S.growoff(cur, gR[i] + 128 * h); gC[h][i] = gN[h][i] * (unsigned)(pitch * 2) + gCb[i]; gS[h][i] = gC[h][i]; } }
    f32x4 acc[2][2][4][2];
#pragma unroll
    for (int a = 0; a < 2; ++a)
#pragma unroll
        for (int b = 0; b < 2; ++b)
#pragma unroll
            for (int m = 0; m < 4; ++m)
#pragma unroll
                for (int n = 0; n < 2; ++n) acc[a][b][m][n] = (f32x4){0.f, 0.f, 0.f, 0.f};
    bf16x8 At[4][2], B0[2][2], B1[2][2];
    const char* cA = S.aptr(cur); const char* cB = S.bptr(cur);
    if constexpr (SP2) {
        PG8_STAGE(PG8_SB(0, 0), cB, voffB); PG8_STAGE(PG8_SB(0, 1), cB + hstep, voffB); PG8_STAGE_A(PG8_SA(0, 0), cA, 0, false); PG8_STAGE_A(PG8_SA(0, 1), cA, 1, false);
        if (wr == 1) PG8_BAR;
        PG8_WAIT_V(2); PG8_BAR;
        PG8_STAGE(PG8_SB(1, 0), cB + kstep, voffB); PG8_STAGE_A(PG8_SA(1, 0), cA + kstep, 0, false); PG8_STAGE(PG8_SB(1, 1), cB + hstep + kstep, voffB);
        PG8_WAIT_V(6); PG8_BAR;
    } else {
        PG8_STAGE(PG8_SB(0, 0), cB, voffB); PG8_STAGE_A(PG8_SA(0, 0), cA, 0, false); PG8_STAGE(PG8_SB(0, 1), cB + hstep, voffB); PG8_STAGE_A(PG8_SA(0, 1), cA, 1, false);
        if (wr == 1) PG8_BAR;
        PG8_WAIT_V(4); PG8_BAR;
        PG8_STAGE(PG8_SB(1, 0), cB + kstep, voffB); PG8_STAGE_A(PG8_SA(1, 0), cA + kstep, 0, false); PG8_STAGE(PG8_SB(1, 1), cB + hstep + kstep, voffB);
        PG8_WAIT_V(6); PG8_BAR;
    }
    for (;;) {
        const bool has_next = S.next(ui + 1, nxt);
        const char* nA = has_next ? S.aptr(nxt) : cA; const char* nB = has_next ? S.bptr(nxt) : cB;
        if constexpr (GATHER) { Unit gu; gu.pm = has_next ? nxt.pm : cur.pm; gu.pn = has_next ? nxt.pn : cur.pn; gu.z = has_next ? nxt.z : cur.z;
#pragma unroll
            for (int h = 0; h < 2; ++h)
#pragma unroll
                for (int i = 0; i < 2; ++i) S.growoff_async(gu, gR[i] + 128 * h, gN[h][i]); }
        for (int t = 0; t < nt; t += 2) {
            const bool last = (t == nt - 2);
            if constexpr (GATHER) { if (t == nt - 4) {
#pragma unroll
                for (int h = 0; h < 2; ++h)
#pragma unroll
                    for (int i = 0; i < 2; ++i) { asm volatile("" : "+v"(gN[h][i]));
                        gS[h][i] = gN[h][i] * (unsigned)(pitch * 2) + gCb[i]; } } }
            const char* a1 = cA + (size_t)(t + 1) * kstep;
            const char* a2 = last ? nA : cA + (size_t)(t + 2) * kstep; const char* b2 = last ? nB : cB + (size_t)(t + 2) * kstep;
            const char* a3 = a2 + kstep; const char* b3 = b2 + kstep;
            if constexpr (SP2) {
            PG8_LDB(B0, 0, 0); PG8_LDB(B1, 0, 1); PG8_SCHED; PG8_LDA(At, 0, 0); PG8_STAGE_A(PG8_SA(1, 1), a1, 1, false);
            PG8_WAIT_V(8); PG8_WAIT_L(0); PG8_BAR; PG8_MMA(0, 0, At, B0); PG8_MMA(0, 1, At, B1); PG8_BAR; PG8_SCHED;
            PG8_LDA(At, 0, 1); PG8_STAGE(PG8_SB(0, 0), b2, voffB); PG8_STAGE(PG8_SB(0, 1), b2 + hstep, voffB); PG8_STAGE_A(PG8_SA(0, 0), a2, 0, last);
            PG8_WAIT_V(8); PG8_WAIT_L(0); PG8_BAR; PG8_MMA(1, 0, At, B0); PG8_MMA(1, 1, At, B1); PG8_BAR; PG8_SCHED;
            PG8_LDB(B0, 1, 0); PG8_LDB(B1, 1, 1); PG8_SCHED; PG8_LDA(At, 1, 0); PG8_STAGE_A(PG8_SA(0, 1), a2, 1, last);
            PG8_WAIT_V(8); PG8_WAIT_L(0); PG8_BAR; PG8_MMA(0, 0, At, B0); PG8_MMA(0, 1, At, B1); PG8_BAR; PG8_SCHED;
            PG8_LDA(At, 1, 1); PG8_STAGE(PG8_SB(1, 0), b3, voffB); PG8_STAGE(PG8_SB(1, 1), b3 + hstep, voffB); PG8_STAGE_A(PG8_SA(1, 0), a3, 0, last);
            PG8_WAIT_V(8); PG8_WAIT_L(0); PG8_BAR; PG8_MMA(1, 0, At, B0); PG8_MMA(1, 1, At, B1); PG8_BAR; PG8_SCHED;
            } else {
            PG8_LDB(B0, 0, 0); PG8_SCHED; PG8_LDA(At, 0, 0); PG8_STAGE_A(PG8_SA(1, 1), a1, 1, false);
            PG8_WAIT_L(8); PG8_BAR; PG8_WAIT_L(0); PG8_MMA(0, 0, At, B0); PG8_BAR; PG8_SCHED;
            PG8_LDB(B1, 0, 1); PG8_STAGE(PG8_SB(0, 0), b2, voffB);
            PG8_BAR; PG8_WAIT_L(0); PG8_MMA(0, 1, At, B1); PG8_BAR;
            PG8_LDA(At, 0, 1); PG8_STAGE_A(PG8_SA(0, 0), a2, 0, last);
            PG8_BAR; PG8_WAIT_L(0); PG8_MMA(1, 0, At, B0); PG8_BAR; PG8_SCHED;
            PG8_STAGE(PG8_SB(0, 1), b2 + hstep, voffB);
            PG8_WAIT_V(6); PG8_BAR; PG8_MMA(1, 1, At, B1); PG8_BAR;
            PG8_LDB(B0, 1, 0); PG8_SCHED; PG8_LDA(At, 1, 0); PG8_STAGE_A(PG8_SA(0, 1), a2, 1, last);
            PG8_WAIT_L(8); PG8_BAR; PG8_WAIT_L(0); PG8_MMA(0, 0, At, B0); PG8_BAR; PG8_SCHED;
            PG8_LDB(B1, 1, 1); PG8_STAGE(PG8_SB(1, 0), b3, voffB);
            PG8_BAR; PG8_WAIT_L(0); PG8_MMA(0, 1, At, B1); PG8_BAR;
            PG8_LDA(At, 1, 1); PG8_STAGE_A(PG8_SA(1, 0), a3, 0, last);
            PG8_BAR; PG8_WAIT_L(0); PG8_MMA(1, 0, At, B0); PG8_BAR; PG8_SCHED;
            PG8_STAGE(PG8_SB(1, 1), b3 + hstep, voffB);
            PG8_WAIT_V(6); PG8_BAR; PG8_MMA(1, 1, At, B1); PG8_BAR;
            }
        }
        if constexpr (ALIGN_EPI) { if (wr == 0) PG8_BAR; }
        E(acc, cur, wr, wc, fr, fq);
        if (!has_next) break;
#pragma unroll
        for (int a = 0; a < 2; ++a)
#pragma unroll
            for (int b = 0; b < 2; ++b)
#pragma unroll
                for (int m = 0; m < 4; ++m)
#pragma unroll
                    for (int n = 0; n < 2; ++n) acc[a][b][m][n] = (f32x4){0.f, 0.f, 0.f, 0.f};
        cur = nxt; cA = nA; cB = nB; ++ui;
        if constexpr (GATHER) {
#pragma unroll
            for (int h = 0; h < 2; ++h)
#pragma unroll
                for (int i = 0; i < 2; ++i) gC[h][i] = gS[h][i]; }
        if constexpr (ALIGN_EPI) { if (wr == 1) PG8_BAR; }
    }
    PG8_WAIT_V(0);
    if constexpr (!ALIGN_EPI) { if (wr == 0) PG8_BAR; }
    PG8_BAR;
#undef PG8_SA
#undef PG8_SB
#undef PG8_STAGE
#undef PG8_STAGE_A
#undef PG8_LDA
#undef PG8_LDB
#undef PG8_MMA
#undef PG8_WAIT_V
#undef PG8_WAIT_L
#undef PG8_BAR
#undef PG8_SCHED
}
}

#ifndef PG8_SP2
#define PG8_SP2 true
#endif
#ifndef PG8_ALIGN
#define PG8_ALIGN true
#endif

constexpr int NWAVES = 8;
constexpr int D = 1024, NB = 8, T = 2048, TC = 256, MX = NB * T, MC = NB * TC, MT = MX + MC;
constexpr int D_IN = 2608, NP = 2560, NPG = 2816, NG = 48, DFF = 2816, DFE = 3584, NE = 8;
constexpr float EPS = 1e-6f;
constexpr int PC_GQ = 0, PC_GK = 128, PC_GV = 256, PC_GG = 512, PC_MQ = 768, PC_MK = 1024, PC_MV = 1280, PC_MO = 1536, PC_SU = 1792, PC_SV = 2048, PC_F = 2304;
constexpr int MOE_TILES = 136, MOE_PASS = 64;

constexpr size_t MiB = 1u << 20;
constexpr size_t WS_CTL = 0, CTL_ZERO_BYTES = 128 * 1024;
constexpr size_t WS_MOD = 1 * MiB;
constexpr size_t WS_ROUTE = 2 * MiB;
constexpr size_t WS_WSGU = 3 * MiB;
constexpr size_t WS_TWCH = 4 * MiB;
constexpr size_t WS_XC = 5 * MiB;
constexpr size_t WS_WTIN = 13 * MiB;
constexpr size_t WS_WTOUT = 24 * MiB;
constexpr size_t WS_WTGU = 28 * MiB;
constexpr size_t WS_WTD = 39 * MiB;
constexpr size_t WS_WTMGU = 45 * MiB;
constexpr size_t WS_WTMD = 157 * MiB;
constexpr size_t WS_R = 213 * MiB;
constexpr size_t WS_HM = WS_R + 0 * MiB;
constexpr size_t WS_P = WS_R + 36 * MiB;
constexpr size_t WS_G = WS_R + 126 * MiB;
constexpr size_t WS_QK = WS_R + 130 * MiB;
constexpr size_t WS_OG = WS_R + 148 * MiB;
constexpr size_t WS_OM = WS_R + 166 * MiB;
constexpr size_t WS_FBX = WS_R + 184 * MiB;
constexpr size_t WS_FBC = WS_R + 200 * MiB;
constexpr size_t WS_TWX = WS_R + 202 * MiB;
constexpr size_t WS_TWC = WS_R + 218 * MiB;
constexpr size_t WS_CPART = WS_R + 219 * MiB;
constexpr size_t WS_SCRG = WS_R + 219 * MiB;
constexpr size_t WS_SCRM = WS_R + 224 * MiB;
constexpr size_t WS_ACTF = WS_R + 36 * MiB;
constexpr size_t WS_XS = WS_R + 36 * MiB;
constexpr size_t WS_ACTM = WS_R + 104 * MiB;
constexpr size_t WS_YLP = WS_R + 0 * MiB;
constexpr size_t WS_PQ = WS_R + 219 * MiB;
constexpr size_t WS_MIXB = WS_R + 234 * MiB;
constexpr size_t WS_XS16 = WS_R + 244 * MiB;
constexpr size_t WS_END = WS_R + 276 * MiB;
constexpr int CW_BAR = 4096;
constexpr int CW_CNT = 16384;

constexpr int RING_BYTES = 131072, WAVE_LDS = 19968, LDSCTL_OFF = 8 * WAVE_LDS, MISC_OFF = LDSCTL_OFF + 320, LDS_BYTES = 163840;
static_assert(MISC_OFF + 128 <= LDS_BYTES && RING_BYTES <= LDSCTL_OFF, "LDS map");

#define GAS __attribute__((address_space(1)))
#define LAS __attribute__((address_space(3)))
typedef unsigned short bf16;
typedef unsigned v4u __attribute__((ext_vector_type(4)));
typedef unsigned v2u __attribute__((ext_vector_type(2)));
typedef float f32x4 __attribute__((ext_vector_type(4)));
typedef GAS unsigned gu32;
#define RLX_AGENT __ATOMIC_RELAXED, __HIP_MEMORY_SCOPE_AGENT
#define LDS_WAIT() asm volatile("s_waitcnt lgkmcnt(0)" ::: "memory")
__device__ __forceinline__ unsigned f2bf(float f) { unsigned u = __builtin_bit_cast(unsigned, f); return (u + 0x7fffu + ((u >> 16) & 1u)) >> 16; }
__device__ __forceinline__ unsigned pk2(float lo, float hi) { return f2bf(lo) | (f2bf(hi) << 16); }
__device__ __forceinline__ float bf2f(bf16 b) { return __builtin_bit_cast(float, ((unsigned)b) << 16); }
__device__ __forceinline__ float bflo(unsigned w) { return __builtin_bit_cast(float, w << 16); }
__device__ __forceinline__ float bfhi(unsigned w) { return __builtin_bit_cast(float, w & 0xffff0000u); }
constexpr float LOG2E = 1.4426950408889634f;
__device__ __forceinline__ float ex2(float x) { return __builtin_amdgcn_exp2f(x); }
__device__ __forceinline__ float lg2(float x) { return __builtin_amdgcn_logf(x); }
__device__ __forceinline__ float sigmoidf_(float x) { return __builtin_amdgcn_rcpf(1.f + ex2(-x * LOG2E)); }
__device__ __forceinline__ float siluf_(float x) { return x * __builtin_amdgcn_rcpf(1.f + ex2(-x * LOG2E)); }
__device__ __forceinline__ float logsigmoidf_(float x) { return fminf(x, 0.f) - log1pf(__expf(-fabsf(x))); }
__device__ __forceinline__ float wave_sum(float v) {
#define WS_DPP(x, ctrl, rmask, bc) __builtin_bit_cast(float, __builtin_amdgcn_update_dpp(0, __builtin_bit_cast(int, (x)), (ctrl), (rmask), 0xf, (bc)))
    v += WS_DPP(v, 0x111, 0xf, true); v += WS_DPP(v, 0x112, 0xf, true); v += WS_DPP(v, 0x114, 0xf, true); v += WS_DPP(v, 0x118, 0xf, true);
    v += WS_DPP(v, 0x142, 0xa, false); v += WS_DPP(v, 0x143, 0xc, false);
#undef WS_DPP
    return __builtin_bit_cast(float, __builtin_amdgcn_readlane(__builtin_bit_cast(int, v), 63));
}

#define XB_TMO      128
#define XB_XCNT(j)  (256  + 64 * (j))
#define XB_XSUB(j)  (1280 + 64 * (j))
#define XB_XGEN(j)  (2304 + 64 * (j))
#define XB_TOP      3328
#define XB_TOPGEN   3392
#define XCD_BAR_WORDS 3456
#define XB_SPIN_CAP (1u << 18)
__device__ __forceinline__ unsigned xb_ld(unsigned* p)              { return __hip_atomic_load(p, __ATOMIC_RELAXED, __HIP_MEMORY_SCOPE_AGENT); }
__device__ __forceinline__ unsigned xb_add(unsigned* p, unsigned v) { return __hip_atomic_fetch_add(p, v, __ATOMIC_RELAXED, __HIP_MEMORY_SCOPE_AGENT); }
__device__ __forceinline__ unsigned xb_xcc_id() { return (unsigned)__builtin_amdgcn_s_getreg((3 << 11) | 20) & 0xFu; }
#define XB_SPIN(cond, bar) do { unsigned _sp = 0; while (cond) { __builtin_amdgcn_s_sleep(1); \
    if ((++_sp & 255u) == 0u) { if (xb_ld(&(bar)[XB_TMO])) break; if (_sp > XB_SPIN_CAP) { atomicAdd(&(bar)[XB_TMO], 1u); break; } } } } while (0)
struct XcdBarrier { unsigned* bar; unsigned x; volatile LAS unsigned* st; };
__device__ __forceinline__ XcdBarrier xcd_barrier_post(unsigned* bar, volatile LAS unsigned* st) {
    XcdBarrier b; b.bar = bar; b.x = xb_xcc_id(); b.st = st;
    if (threadIdx.x == 0) (void)xb_add(&bar[XB_XCNT(b.x)], 1u);
    return b;
}
__device__ __forceinline__ void xcd_barrier_complete(unsigned* bar, unsigned x, unsigned& nloc, unsigned& nx) {
    const unsigned G = gridDim.x * gridDim.y * gridDim.z;
    unsigned sum, cnt, mine, sp = 0u;
    for (;;) {
        sum = 0u; cnt = 0u; mine = 0u;
#pragma unroll
        for (unsigned j = 0; j < 16; ++j) { const unsigned c = xb_ld(&bar[XB_XCNT(j)]); sum += c; cnt += (c > 0u) ? 1u : 0u; mine = (j == x) ? c : mine; }
        if (sum == G) break;
        __builtin_amdgcn_s_sleep(1);
        if ((++sp & 255u) == 0u) { if (xb_ld(&bar[XB_TMO])) break; if (sp > XB_SPIN_CAP) { atomicAdd(&bar[XB_TMO], 1u); break; } }
    }
    nloc = mine > 0u ? mine : 1u; nx = cnt > 0u ? cnt : 1u;
}
__device__ __forceinline__ void xcd_barrier(const XcdBarrier& b) {
    asm volatile("s_waitcnt vmcnt(0)" ::: "memory");
    __syncthreads();
    if (threadIdx.x == 0) {
        unsigned* bar = b.bar;
        __builtin_amdgcn_s_waitcnt(0);
        unsigned nloc = b.st[0], nx = b.st[1];
        if (nloc == 0u) { xcd_barrier_complete(bar, b.x, nloc, nx); b.st[0] = nloc; b.st[1] = nx; }
        const unsigned old = xb_add(&bar[XB_XSUB(b.x)], 1u);
        const unsigned gen = old / nloc;
        if (old + 1u == (gen + 1u) * nloc) {
            __builtin_amdgcn_fence(__ATOMIC_RELEASE, "agent");
            asm volatile("s_waitcnt vmcnt(0)" ::: "memory");
            const unsigned og = xb_add(&bar[XB_TOP], 1u);
            const unsigned tg = og / nx;
            if (og + 1u == (tg + 1u) * nx) xb_add(&bar[XB_TOPGEN], 1u);
            else XB_SPIN(xb_ld(&bar[XB_TOPGEN]) == tg, bar);
            __builtin_amdgcn_fence(__ATOMIC_ACQUIRE, "agent");
            asm volatile("s_waitcnt vmcnt(0)" ::: "memory");
        } else {
            XB_SPIN(xb_ld(&bar[XB_TOPGEN]) == gen, bar);
            __builtin_amdgcn_fence(__ATOMIC_ACQUIRE, "agent");
            asm volatile("s_waitcnt vmcnt(0)" ::: "memory");
        }
    }
    __syncthreads();
}

struct DenseSched {
    const char* A; const char* Bt; size_t tstep; pg8::StaticOrder o;
    __device__ __forceinline__ void init(const void* A_, const void* Bt_, int nM, int nN, int K, int G, int c) { A = (const char*)A_; Bt = (const char*)Bt_; tstep = (size_t)256 * K * 2; o.init(nM, nN, G, c); }
    __device__ __forceinline__ bool next(int i, pg8::Unit& u) const { return o.next(i, u); }
    __device__ __forceinline__ const char* aptr(const pg8::Unit& u) const { return A + (size_t)u.pm * tstep; }
    __device__ __forceinline__ const char* bptr(const pg8::Unit& u) const { return Bt + (size_t)u.pn * tstep; }
};
struct InProjSched {
    const char* A; const char* Bt; size_t tstep; int nctx, G, c; pg8::StaticOrder o;
    __device__ __forceinline__ void init(const void* A_, const void* Bt_, int nctx_, int G_, int c_) { A = (const char*)A_; Bt = (const char*)Bt_; tstep = (size_t)256 * D * 2; nctx = nctx_; G = G_; c = c_; o.init(64, 11, G_, c_); }
    __device__ __forceinline__ bool next(int i, pg8::Unit& u) const {
        if (o.next(i, u)) return true;
        const int L = i * G + c - 64 * 11; if (L >= 8 * nctx) return false;
        u.pm = 64 + L / nctx; const int q = L % nctx; u.pn = (nctx == 11 || q < 7) ? q : 10; u.z = 0; return true; }
    __device__ __forceinline__ const char* aptr(const pg8::Unit& u) const { return A + (size_t)u.pm * tstep; }
    __device__ __forceinline__ const char* bptr(const pg8::Unit& u) const { return Bt + (size_t)u.pn * tstep; }
};
struct BatchSched {
    const char* A; const char* Bt; size_t tstep, zstride, hbytes; int nunits, npm, G, c;
    __device__ __forceinline__ bool next(int i, pg8::Unit& u) const { const int L = i * G + c; if (L < 0 || L >= nunits) return false; u.z = L / (2 * npm); const int rem = L % (2 * npm); u.pm = rem >> 1; u.pn = rem & 1; return true; }
    __device__ __forceinline__ const char* aptr(const pg8::Unit& u) const { return A + (size_t)u.pm * tstep + (size_t)u.pn * hbytes; }
    __device__ __forceinline__ const char* bptr(const pg8::Unit& u) const { return Bt + (size_t)u.z * zstride + (size_t)u.pn * hbytes; }
};
struct EpiFourier {
    static constexpr bool PERM = true;
    bf16* O0; int ld0; size_t zs0; bf16* O1; int ld1; size_t zs1;
    __device__ __forceinline__ void operator()(const pg8::f32x4 (&acc)[2][2][4][2], const pg8::Unit& u, int wr, int wc, int fr, int fq) const {
        const int half = __builtin_amdgcn_readfirstlane(u.pn), uz = __builtin_amdgcn_readfirstlane(u.z);
        const int row0 = u.pm * 256 + wr * 64 + fr, col0 = wc * 32 + 8 * fq; const int ldc = half ? ld1 : ld0; bf16* base = half ? O1 + (size_t)uz * zs1 : O0 + (size_t)uz * zs0;
#pragma unroll
        for (int ai = 0; ai < 2; ++ai)
#pragma unroll
            for (int m = 0; m < 4; ++m) { bf16* rowp = base + (size_t)(row0 + ai * 128 + m * 16) * ldc + col0;
#pragma unroll
                for (int bj = 0; bj < 2; ++bj) { const pg8::f32x4 v0 = acc[ai][bj][m][0], v1 = acc[ai][bj][m][1];
                    pg8::u32x4 w; w.x = pg8::cvt_pk_bf16(v0[0], v0[1]); w.y = pg8::cvt_pk_bf16(v0[2], v0[3]); w.z = pg8::cvt_pk_bf16(v1[0], v1[1]); w.w = pg8::cvt_pk_bf16(v1[2], v1[3]);
                    *(pg8::u32x4*)(rowp + bj * 128) = w; } }
    }
};
constexpr int PQ_ROWS = 1025;
struct FourierSymSched {
    const char* A; const char* Bt; int G, c;
    __device__ __forceinline__ bool next(int i, pg8::Unit& u) const { const int L = i * G + c; if (L < 0 || L >= 128) return false; u.z = L >> 4; u.pm = (L >> 2) & 3; u.pn = L & 3; return true; }
    __device__ __forceinline__ const char* aptr(const pg8::Unit& u) const { return A + (size_t)u.pm * ((size_t)256 * 4096 * 2) + (size_t)(u.pn >> 1) * (2048 * 2) + (size_t)(u.pn & 1) * (1024 * 2); }
    __device__ __forceinline__ const char* bptr(const pg8::Unit& u) const { return Bt + (size_t)u.z * ((size_t)256 * 4096 * 2) + (size_t)(u.pn >> 1) * (2048 * 2) + (size_t)(u.pn & 1) * (1024 * 2); }
};
struct EpiFourierSym {
    static constexpr bool PERM = true;
    bf16* PQ;
    __device__ __forceinline__ void operator()(const pg8::f32x4 (&acc)[2][2][4][2], const pg8::Unit& u, int wr, int wc, int fr, int fq) const {
        const int row0 = u.pm * 256 + wr * 64 + fr, col0 = wc * 32 + 8 * fq; bf16* base = PQ + ((size_t)(((u.pn >> 1) * 2 + (u.pn & 1)) * 8 + u.z) * PQ_ROWS) * 256;
#pragma unroll
        for (int ai = 0; ai < 2; ++ai)
#pragma unroll
            for (int m = 0; m < 4; ++m) { bf16* rowp = base + (size_t)(row0 + ai * 128 + m * 16) * 256 + col0;
#pragma unroll
                for (int bj = 0; bj < 2; ++bj) { const pg8::f32x4 v0 = acc[ai][bj][m][0], v1 = acc[ai][bj][m][1];
                    pg8::u32x4 w; w.x = pg8::cvt_pk_bf16(v0[0], v0[1]); w.y = pg8::cvt_pk_bf16(v0[2], v0[3]); w.z = pg8::cvt_pk_bf16(v1[0], v1[1]); w.w = pg8::cvt_pk_bf16(v1[2], v1[3]);
                    *(pg8::u32x4*)(rowp + bj * 128) = w; } }
    }
};
struct MoeSched {
    const char* A; const char* W; size_t tstepA, tstepW, estride; int tb[9]; int t0; pg8::StaticOrder o;
    __device__ __forceinline__ bool next(int i, pg8::Unit& u) const {
        if (!o.next(i, u)) return false; const int gt = t0 + u.pm; int e = 0;
#pragma unroll
        for (int j = 1; j < 8; ++j) e += (gt >= tb[j]) ? 1 : 0;
        u.z = e; return true; }
    __device__ __forceinline__ const char* aptr(const pg8::Unit& u) const { return A + (size_t)u.pm * tstepA; }
    __device__ __forceinline__ const char* bptr(const pg8::Unit& u) const { return W + (size_t)u.z * estride + (size_t)u.pn * tstepW; }
};

struct MoeGatherSched {
    const char* A; const char* W; size_t tstepW, estride; const int* LIST; int tb[9]; int cnt[8]; int t0; pg8::StaticOrder o;
    __device__ __forceinline__ bool next(int i, pg8::Unit& u) const {
        if (!o.next(i, u)) return false; const int gt = t0 + u.pm; int e = 0;
#pragma unroll
        for (int j = 1; j < 8; ++j) e += (gt >= tb[j]) ? 1 : 0;
        int tbe = 0;
#pragma unroll
        for (int j = 0; j < 8; ++j) tbe = (e == j) ? tb[j] : tbe;
        u.z = e | ((gt - tbe) << 4); return true; }
    __device__ __forceinline__ const char* aptr(const pg8::Unit&) const { return A; }
    __device__ __forceinline__ const char* bptr(const pg8::Unit& u) const { return W + (size_t)(u.z & 15) * estride + (size_t)u.pn * tstepW; }
    __device__ __forceinline__ unsigned growoff(const pg8::Unit& u, const int r) const {
        const int e = u.z & 15, pos = (u.z >> 4) * 256 + r; int ce = 0;
#pragma unroll
        for (int j = 0; j < 8; ++j) ce = (e == j) ? cnt[j] : ce;
        const int pc = pos < ce ? pos : ce - 1; return (unsigned)LIST[e * MX + (pc > 0 ? pc : 0)]; }
    __device__ __forceinline__ void growoff_async(const pg8::Unit& u, const int r, unsigned& dst) const {
        const int e = u.z & 15, pos = (u.z >> 4) * 256 + r; int ce = 0;
#pragma unroll
        for (int j = 0; j < 8; ++j) ce = (e == j) ? cnt[j] : ce;
        const int pc = pos < ce ? pos : ce - 1; const int* p = LIST + (e * MX + (pc > 0 ? pc : 0));
        asm volatile("global_load_dword %0, %1, off" : "=v"(dst) : "v"(p) : "memory"); }
};

struct CtxSplitSched {
    const char* A; const char* Bt; size_t tstep, kbytes; int G, c;
    __device__ __forceinline__ bool next(int i, pg8::Unit& u) const { const int L = i * G + c; if (L >= 64) return false; u.pm = L >> 3; u.pn = ((L >> 1) & 3) | ((L & 1) << 2); u.z = 0; return true; }
    __device__ __forceinline__ const char* aptr(const pg8::Unit& u) const { return A + (size_t)u.pm * tstep + (size_t)(u.pn >> 2) * kbytes; }
    __device__ __forceinline__ const char* bptr(const pg8::Unit& u) const { return Bt + (size_t)(u.pn & 3) * tstep + (size_t)(u.pn >> 2) * kbytes; }
};
struct CtxSplit4Sched {
    const char* A; const char* Bt; size_t tstep, kbytes; int G, c;
    __device__ __forceinline__ bool next(int i, pg8::Unit& u) const { const int L = i * G + c; if (L >= 128) return false; u.pm = L >> 4; u.pn = ((L >> 2) & 3) | ((L & 3) << 2); u.z = 0; return true; }
    __device__ __forceinline__ const char* aptr(const pg8::Unit& u) const { return A + (size_t)u.pm * tstep + (size_t)(u.pn >> 2) * kbytes; }
    __device__ __forceinline__ const char* bptr(const pg8::Unit& u) const { return Bt + (size_t)(u.pn & 3) * tstep + (size_t)(u.pn >> 2) * kbytes; }
};
struct KSplitSched {
    const char* A; const char* W; size_t tstepA, tstepW, estride; int tb[9]; int nunits, G, c;
    __device__ __forceinline__ bool next(int i, pg8::Unit& u) const {
        const int L = i * G + c; if (L >= nunits) return false; u.pm = L / 28; u.pn = L - u.pm * 28; const int gt = 128 + u.pm; int e = 0;
#pragma unroll
        for (int j = 1; j < 8; ++j) e += (gt >= tb[j]) ? 1 : 0;
        u.z = e; return true; }
    __device__ __forceinline__ const char* aptr(const pg8::Unit& u) const { return A + (size_t)u.pm * tstepA + (size_t)(u.pn >> 2) * (512 * 2); }
    __device__ __forceinline__ const char* bptr(const pg8::Unit& u) const { return W + (size_t)u.z * estride + (size_t)(u.pn & 3) * tstepW + (size_t)(u.pn >> 2) * (512 * 2); }
};
struct EpiKSplit {
    static constexpr bool PERM = true;
    bf16* O; size_t kstride;
    __device__ __forceinline__ void operator()(const pg8::f32x4 (&acc)[2][2][4][2], const pg8::Unit& u, int wr, int wc, int fr, int fq) const {
        const int row0 = u.pm * 256 + wr * 64 + fr, col0 = (u.pn & 3) * 256 + wc * 32 + 8 * fq; bf16* base = O + (size_t)(u.pn >> 2) * kstride;
#pragma unroll
        for (int ai = 0; ai < 2; ++ai)
#pragma unroll
            for (int m = 0; m < 4; ++m) { bf16* rowp = base + (size_t)(row0 + ai * 128 + m * 16) * D + col0;
#pragma unroll
                for (int bj = 0; bj < 2; ++bj) { const pg8::f32x4 v0 = acc[ai][bj][m][0], v1 = acc[ai][bj][m][1];
                    pg8::u32x4 w; w.x = pg8::cvt_pk_bf16(v0[0], v0[1]); w.y = pg8::cvt_pk_bf16(v0[2], v0[3]); w.z = pg8::cvt_pk_bf16(v1[0], v1[1]); w.w = pg8::cvt_pk_bf16(v1[2], v1[3]);
                    *(pg8::u32x4*)(rowp + bj * 128) = w; } }
    }
};
struct EpiBf16Plain {
    static constexpr bool PERM = true;
    bf16* O; int ldc; size_t zstride;
    __device__ __forceinline__ void operator()(const pg8::f32x4 (&acc)[2][2][4][2], const pg8::Unit& u, int wr, int wc, int fr, int fq) const {
        const int row0 = u.pm * 256 + wr * 64 + fr, col0 = u.pn * 256 + wc * 32 + 8 * fq; bf16* base = O + (size_t)u.z * zstride;
#pragma unroll
        for (int ai = 0; ai < 2; ++ai)
#pragma unroll
            for (int m = 0; m < 4; ++m) { bf16* rowp = base + (size_t)(row0 + ai * 128 + m * 16) * ldc + col0;
#pragma unroll
                for (int bj = 0; bj < 2; ++bj) { const pg8::f32x4 v0 = acc[ai][bj][m][0], v1 = acc[ai][bj][m][1];
                    pg8::u32x4 w; w.x = pg8::cvt_pk_bf16(v0[0], v0[1]); w.y = pg8::cvt_pk_bf16(v0[2], v0[3]); w.z = pg8::cvt_pk_bf16(v1[0], v1[1]); w.w = pg8::cvt_pk_bf16(v1[2], v1[3]);
                    *(pg8::u32x4*)(rowp + bj * 128) = w; } }
    }
};
struct EpiInProj {
    static constexpr bool PERM = true;
    bf16* O; float* GT;
    __device__ __forceinline__ void operator()(const pg8::f32x4 (&acc)[2][2][4][2], const pg8::Unit& u, int wr, int wc, int fr, int fq) const {
        const int row0 = u.pm * 256 + wr * 64 + fr;
        if (u.pn < NP / 256) {
            const int col0 = u.pn * 256 + wc * 32 + 8 * fq;
#pragma unroll
            for (int ai = 0; ai < 2; ++ai)
#pragma unroll
                for (int m = 0; m < 4; ++m) { bf16* rowp = O + (size_t)(row0 + ai * 128 + m * 16) * NP + col0;
#pragma unroll
                    for (int bj = 0; bj < 2; ++bj) { const pg8::f32x4 v0 = acc[ai][bj][m][0], v1 = acc[ai][bj][m][1];
                        pg8::u32x4 w; w.x = pg8::cvt_pk_bf16(v0[0], v0[1]); w.y = pg8::cvt_pk_bf16(v0[2], v0[3]); w.z = pg8::cvt_pk_bf16(v1[0], v1[1]); w.w = pg8::cvt_pk_bf16(v1[2], v1[3]);
                        *(pg8::u32x4*)(rowp + bj * 128) = w; } }
        } else {
            const int col0 = wc * 32 + 8 * fq;
            if (col0 < NG) {
#pragma unroll
                for (int ai = 0; ai < 2; ++ai)
#pragma unroll
                    for (int m = 0; m < 4; ++m) { float* rowp = GT + (size_t)(row0 + ai * 128 + m * 16) * NG + col0;
                        *(pg8::f32x4*)rowp = acc[ai][0][m][0]; *(pg8::f32x4*)(rowp + 4) = acc[ai][0][m][1]; } }
        }
    }
};
struct EpiSwiGLU {
    static constexpr bool PERM = true;
    bf16* O; int ldc;
    __device__ __forceinline__ void operator()(const pg8::f32x4 (&acc)[2][2][4][2], const pg8::Unit& u, int wr, int wc, int fr, int fq) const {
        const int row0 = u.pm * 256 + wr * 64 + fr, col0 = u.pn * 128 + wc * 32 + 8 * fq;
#pragma unroll
        for (int ai = 0; ai < 2; ++ai)
#pragma unroll
            for (int m = 0; m < 4; ++m) { bf16* rowp = O + (size_t)(row0 + ai * 128 + m * 16) * ldc + col0;
                float r[8];
#pragma unroll
                for (int n = 0; n < 2; ++n)
#pragma unroll
                    for (int j = 0; j < 4; ++j) { const float g = acc[ai][0][m][n][j], uu = acc[ai][1][m][n][j]; r[n * 4 + j] = g * uu * __builtin_amdgcn_rcpf(1.f + ex2(-g * LOG2E)); }
                pg8::u32x4 w; w.x = pg8::cvt_pk_bf16(r[0], r[1]); w.y = pg8::cvt_pk_bf16(r[2], r[3]); w.z = pg8::cvt_pk_bf16(r[4], r[5]); w.w = pg8::cvt_pk_bf16(r[6], r[7]);
                *(pg8::u32x4*)rowp = w; }
    }
};
struct EpiResGate {
    static constexpr bool PERM = false;
    const float* xbase; float* xout; const float* cbase; float* cout; const float* modl; int goff;
    __device__ __forceinline__ void operator()(const pg8::f32x4 (&acc)[2][2][4][2], const pg8::Unit& u, int wr, int wc, int fr, int fq) const {
        const float* basep; float* outp; int bidx;
        if (u.pm < 64) { bidx = u.pm >> 3; basep = xbase + (size_t)u.pm * 256 * D; outp = xout + (size_t)u.pm * 256 * D; }
        else { bidx = 8; basep = cbase + (size_t)(u.pm - 64) * 256 * D; outp = cout + (size_t)(u.pm - 64) * 256 * D; }
        const float* gatep = modl + bidx * 6144 + goff;
        const int col0 = u.pn * 256 + wc * 32 + 4 * fq, r0 = wr * 64 + fr;
        pg8::f32x4 gv[2][2];
#pragma unroll
        for (int bj = 0; bj < 2; ++bj)
#pragma unroll
            for (int n = 0; n < 2; ++n) gv[bj][n] = *(const pg8::f32x4*)(gatep + col0 + bj * 128 + n * 16);
#pragma unroll
        for (int ai = 0; ai < 2; ++ai)
#pragma unroll
            for (int m = 0; m < 4; ++m) { const size_t off = (size_t)(r0 + ai * 128 + m * 16) * D + col0;
#pragma unroll
                for (int bj = 0; bj < 2; ++bj)
#pragma unroll
                    for (int n = 0; n < 2; ++n) { const pg8::f32x4 bs = *(const pg8::f32x4*)(basep + off + bj * 128 + n * 16);
                        *(pg8::f32x4*)(outp + off + bj * 128 + n * 16) = bs + gv[bj][n] * acc[ai][bj][m][n]; } }
    }
};


typedef short s16x4 __attribute__((ext_vector_type(4)));
typedef short bf16x8v __attribute__((ext_vector_type(8)));
template <int CTRL> __device__ __forceinline__ float dpp_f0(float x) { return __builtin_bit_cast(float, __builtin_amdgcn_update_dpp(0, __builtin_bit_cast(int, x), CTRL, 0xf, 0xf, true)); }
template <int CTRL> __device__ __forceinline__ float dpp_fninf(float x) { return __builtin_bit_cast(float, __builtin_amdgcn_update_dpp((int)0xff800000u, __builtin_bit_cast(int, x), CTRL, 0xf, 0xf, false)); }
template <int CTRL> __device__ __forceinline__ float dpp_any(float x) { return __builtin_bit_cast(float, __builtin_amdgcn_update_dpp(0, __builtin_bit_cast(int, x), CTRL, 0xf, 0xf, false)); }
__device__ __forceinline__ float row_bcast15(float x) { return dpp_any<0x15F>(x); }
__device__ __forceinline__ float row_sum16(float x) { x += dpp_any<0x121>(x); x += dpp_any<0x122>(x); x += dpp_any<0x124>(x); x += dpp_any<0x128>(x); return x; }
__device__ __forceinline__ float quad_sum4(float x) { x += dpp_any<0xB1>(x); x += dpp_any<0x4E>(x); return x; }
__device__ __forceinline__ float lane_bcast(float x, int l) { return __builtin_bit_cast(float, __builtin_amdgcn_readlane(__builtin_bit_cast(int, x), l)); }
__device__ __forceinline__ float row_scan_add(float x) { x += dpp_f0<0x111>(x); x += dpp_f0<0x112>(x); x += dpp_f0<0x114>(x); x += dpp_f0<0x118>(x); return x; }
__device__ __forceinline__ float row_scan_max(float x) { x = fmaxf(x, dpp_fninf<0x111>(x)); x = fmaxf(x, dpp_fninf<0x112>(x)); x = fmaxf(x, dpp_fninf<0x114>(x)); x = fmaxf(x, dpp_fninf<0x118>(x)); return x; }
__device__ __forceinline__ bf16x8v pack8(const float (&v)[8]) { v4u w; w.x = pg8::cvt_pk_safe(v[0], v[1]); w.y = pg8::cvt_pk_safe(v[2], v[3]); w.z = pg8::cvt_pk_safe(v[4], v[5]); w.w = pg8::cvt_pk_safe(v[6], v[7]); return __builtin_bit_cast(bf16x8v, w); }
__device__ __forceinline__ bf16x8v cat4(s16x4 lo, s16x4 hi) { return __builtin_shufflevector(lo, hi, 0, 1, 2, 3, 4, 5, 6, 7); }
__device__ __forceinline__ s16x4 tr_read(LAS unsigned char* p) { return __builtin_amdgcn_ds_read_tr16_b64_v4i16((LAS s16x4*)p); }
#define MFMA16(a, b, c) __builtin_amdgcn_mfma_f32_16x16x32_bf16((a), (b), (c), 0, 0, 0)

constexpr int GL_V = 0, GL_K2 = 9216, GL_SC = 14336, GL_MISC = 16640;
constexpr int SCRG_SEQ = 81920;
#define WG_SYNC_GLOBAL() do { asm volatile("s_waitcnt vmcnt(0)" ::: "memory"); __syncthreads(); __builtin_amdgcn_fence(__ATOMIC_ACQUIRE, "agent"); } while (0)
template <int l>
__device__ __forceinline__ void gla_scan(LAS unsigned char* lds, unsigned char* ws, const float* w_lr, const float* b_lr, const int seq, const int wave, const int lane_in, const bool ctx_out) {
    const int b = seq >> 3, h = (seq >> 1) & 3, dir = seq & 1;
    LAS unsigned char* W = lds + wave * WAVE_LDS;
    const bf16* P = (const bf16*)(ws + WS_P); const float* GT = (const float*)(ws + WS_G); bf16* OG = (bf16*)(ws + WS_OG);
    const int r = lane_in & 15, g = lane_in >> 4;
    bf16x8v wfrag[2]; float bias[2][4];
#pragma unroll
    for (int dt = 0; dt < 2; ++dt) { float t[8];
#pragma unroll
        for (int j = 0; j < 8; ++j) t[j] = g < 2 ? w_lr[((size_t)(l * 2 + dir) * 16 + 8 * g + j) * 128 + h * 32 + 16 * dt + r] : 0.f;
        wfrag[dt] = pack8(t);
#pragma unroll
        for (int rg = 0; rg < 4; ++rg) bias[dt][rg] = b_lr[(l * 2 + dir) * 128 + h * 32 + 16 * dt + 4 * g + rg]; }
    const pg8::f32x4 zero4 = {0.f, 0.f, 0.f, 0.f};
    pg8::f32x4 Sown = zero4;
    for (int round = 0; round < 5; ++round) {
        int lane = lane_in; asm volatile("" : "+v"(lane));
        const int r = lane & 15, g = lane >> 4, q4 = r >> 2, p4 = lane & 3;
        const int n = round * 8 + wave; const bool active = n < 36;
        int rowbase = 0;
        if (n < 4) rowbase = MX + b * TC + (dir ? 3 - n : n) * 64; else rowbase = b * T + (dir ? 35 - n : n - 4) * 64;
        const int rsgn = dir ? -1 : 1, roff = dir ? rowbase + 63 : rowbase;
        bf16x8v Qf[4], Vf[4][2], K2f[2][2]; pg8::f32x4 O[4][4];
        if (active) {
#pragma unroll
            for (int it = 0; it < 8; ++it) { const int sp = it * 8 + (lane >> 3);
                const v4u x = *(const v4u*)(P + (size_t)(roff + rsgn * sp) * NP + PC_GV + h * 64 + (lane & 7) * 8);
                *(LAS v4u*)(W + GL_V + sp * 144 + (lane & 7) * 16) = x; }
            v2u qp[4][2], kp[4][2]; float la[4][8];
#pragma unroll
            for (int i = 0; i < 4; ++i) { const size_t tok = (size_t)(roff + rsgn * (16 * i + r));
                qp[i][0] = *(const v2u*)(P + tok * NP + PC_GQ + h * 32 + 4 * g); qp[i][1] = *(const v2u*)(P + tok * NP + PC_GQ + h * 32 + 16 + 4 * g);
                kp[i][0] = *(const v2u*)(P + tok * NP + PC_GK + h * 32 + 4 * g); kp[i][1] = *(const v2u*)(P + tok * NP + PC_GK + h * 32 + 16 + 4 * g);
                float lr[8];
                {
                    const f32x4 a0 = *(const f32x4*)(GT + tok * NG + dir * 16 + 8 * (g & 1)), a1 = *(const f32x4*)(GT + tok * NG + dir * 16 + 8 * (g & 1) + 4); const bool lo = g < 2;
                    lr[0] = lo ? a0.x : 0.f; lr[1] = lo ? a0.y : 0.f; lr[2] = lo ? a0.z : 0.f; lr[3] = lo ? a0.w : 0.f; lr[4] = lo ? a1.x : 0.f; lr[5] = lo ? a1.y : 0.f; lr[6] = lo ? a1.z : 0.f; lr[7] = lo ? a1.w : 0.f; }
                const bf16x8v lrf = pack8(lr);
#pragma unroll
                for (int dt = 0; dt < 2; ++dt) { const pg8::f32x4 z = MFMA16(wfrag[dt], lrf, zero4);
#pragma unroll
                    for (int rg = 0; rg < 4; ++rg) { const float zz = z[rg] + bias[dt][rg]; la[i][dt * 4 + rg] = (fminf(zz, 0.f) * LOG2E - lg2(1.f + ex2(-fabsf(zz) * LOG2E))) * (1.f / 16.f); } } }
            float cl[8];
#pragma unroll
            for (int j = 0; j < 8; ++j) { float carry = 0.f;
#pragma unroll
                for (int i = 0; i < 4; ++i) { const float x = row_scan_add(la[i][j]) + carry; la[i][j] = x; carry = row_bcast15(x); }
                cl[j] = carry; }
            bf16x8v Kf[4]; float ecl[8];
#pragma unroll
            for (int j = 0; j < 8; ++j) ecl[j] = ex2(cl[j]);
#pragma unroll
            for (int i = 0; i < 4; ++i) { float tq[8], tk[8], t2[8];
                const float qv[8] = {bflo(qp[i][0].x), bfhi(qp[i][0].x), bflo(qp[i][0].y), bfhi(qp[i][0].y), bflo(qp[i][1].x), bfhi(qp[i][1].x), bflo(qp[i][1].y), bfhi(qp[i][1].y)};
                const float kv[8] = {bflo(kp[i][0].x), bfhi(kp[i][0].x), bflo(kp[i][0].y), bfhi(kp[i][0].y), bflo(kp[i][1].x), bfhi(kp[i][1].x), bflo(kp[i][1].y), bfhi(kp[i][1].y)};
#pragma unroll
                for (int j = 0; j < 8; ++j) { const float e1 = ex2(la[i][j]), kinv = kv[j] * __builtin_amdgcn_rcpf(e1); tq[j] = qv[j] * 0.17677669529663687f * e1; tk[j] = kinv; t2[j] = kinv * ecl[j]; }
                Qf[i] = pack8(tq); Kf[i] = pack8(tk);
                *(LAS bf16x8v*)(W + GL_K2 + (16 * i + r) * 80 + 16 * g) = pack8(t2); }
            if (r == 0) {
#pragma unroll
                for (int j = 0; j < 8; ++j) ((LAS float*)(W + GL_MISC))[8 * g + j] = ecl[j]; }
#pragma unroll
            for (int dt = 0; dt < 4; ++dt)
#pragma unroll
                for (int ks = 0; ks < 2; ++ks) { LAS unsigned char* a = W + GL_V + (32 * ks + 8 * g + q4) * 144 + (16 * dt + 4 * p4) * 2; Vf[dt][ks] = cat4(tr_read(a), tr_read(a + 4 * 144)); }
#pragma unroll
            for (int dd = 0; dd < 2; ++dd)
#pragma unroll
                for (int ks = 0; ks < 2; ++ks) { LAS unsigned char* a = W + GL_K2 + (32 * ks + 8 * g + q4) * 80 + (16 * dd + 4 * p4) * 2; K2f[dd][ks] = cat4(tr_read(a), tr_read(a + 4 * 80)); }
#pragma unroll
            for (int li = 0; li < 4; ++li) {
#pragma unroll
                for (int si = 0; si < 4; ++si) { pg8::f32x4 dd4 = zero4;
                    if (si <= li) { dd4 = MFMA16(Kf[si], Qf[li], zero4);
                        if (si == li) {
#pragma unroll
                            for (int rg = 0; rg < 4; ++rg) dd4[rg] = (r >= 4 * g + rg) ? dd4[rg] : 0.f; } }
                    v2u w; w.x = pg8::cvt_pk_safe(dd4[0], dd4[1]); w.y = pg8::cvt_pk_safe(dd4[2], dd4[3]);
                    *(LAS v2u*)(W + GL_SC + r * 144 + (16 * si + 4 * g) * 2) = w; }
#pragma unroll
                for (int ks = 0; ks < 2; ++ks) { const bf16x8v scf = *(const LAS bf16x8v*)(W + GL_SC + r * 144 + (32 * ks + 8 * g) * 2);
#pragma unroll
                    for (int dt = 0; dt < 4; ++dt) O[dt][li] = MFMA16(Vf[dt][ks], scf, ks == 0 ? zero4 : O[dt][li]); }
            }
        }
        __syncthreads();
        if (active) {
#pragma unroll
            for (int dd = 0; dd < 2; ++dd)
#pragma unroll
                for (int dt = 0; dt < 4; ++dt) { pg8::f32x4 U = MFMA16(K2f[dd][0], Vf[dt][0], zero4); U = MFMA16(K2f[dd][1], Vf[dt][1], U);
                    *(LAS pg8::f32x4*)(lds + (dd * 4 + dt) * WAVE_LDS + GL_V + wave * 1024 + lane * 16) = U; }
        }
        __syncthreads();
        {
            const int odd = wave >> 2, odt = wave & 3;
            pg8::f32x4 Uj[8], Dj[8];
#pragma unroll
            for (int j = 0; j < 8; ++j) { Uj[j] = *(const LAS pg8::f32x4*)(W + GL_V + j * 1024 + lane * 16); Dj[j] = *(const LAS pg8::f32x4*)(lds + j * WAVE_LDS + GL_MISC + (16 * odd + 4 * g) * 4); }
#pragma unroll
            for (int j = 0; j < 8; ++j) if (round * 8 + j < 36) {
                v2u w; w.x = pg8::cvt_pk_safe(Sown[0], Sown[1]); w.y = pg8::cvt_pk_safe(Sown[2], Sown[3]);
                *(LAS v2u*)(lds + j * WAVE_LDS + GL_K2 + (16 * odt + r) * 80 + (16 * odd + 4 * g) * 2) = w;
                Sown = Dj[j] * Sown + Uj[j]; }
        }
        __syncthreads();
        if (active) {
#pragma unroll
            for (int dt = 0; dt < 4; ++dt) { const bf16x8v stf = *(const LAS bf16x8v*)(W + GL_K2 + (16 * dt + r) * 80 + 16 * g);
#pragma unroll
                for (int li = 0; li < 4; ++li) O[dt][li] = MFMA16(stf, Qf[li], O[dt][li]); }
            if (n >= 4 || ctx_out) {
#pragma unroll
                for (int li = 0; li < 4; ++li) { bf16* orow = OG + ((size_t)dir * MT + (size_t)(roff + rsgn * (16 * li + r))) * 256 + h * 64 + 4 * g;
#pragma unroll
                    for (int dt = 0; dt < 4; ++dt) { v2u w; w.x = pg8::cvt_pk_safe(O[dt][li][0], O[dt][li][1]); w.y = pg8::cvt_pk_safe(O[dt][li][2], O[dt][li][3]); *(v2u*)(orow + 16 * dt) = w; } } }
        }
    }
}


#ifndef MLREP_A
#define MLREP_A 1
#endif
#ifndef MLREP_B
#define MLREP_B 1
#endif
#ifndef MLREP_D
#define MLREP_D 1
#endif
constexpr int ML_V = 0, ML_KW = 8192, ML_SC = 16384, ML_B = 18688, ML_PM = 18944, ML_CUM = 19200, ML_DMX = 19456, ML_N = 19712;
constexpr int SCRM_SLOT = 4224, SCRM_SEQ = 9 * SCRM_SLOT * 4;
__device__ __forceinline__ int ml_sw(const int row) { return ((row ^ ((row >> 1) & 4)) & 7) << 4; }
template <int l>
__device__ __forceinline__ void mlstm_scan(LAS unsigned char* lds, unsigned char* ws, const float* gate_b, const int seq, const int wave, const int lane_in, const bool ctx_out) {
    const int b = seq >> 3, h = (seq >> 1) & 3, dir = seq & 1;
    LAS unsigned char* W = lds + wave * WAVE_LDS;
    const bf16* P = (const bf16*)(ws + WS_P); const bf16* QK = (const bf16*)(ws + WS_QK); const float* GT = (const float*)(ws + WS_G); bf16* OM = (bf16*)(ws + WS_OM);
    const float gbi = gate_b[((l * 2 + dir) * 2 + 0) * 4 + h], gbf = gate_b[((l * 2 + dir) * 2 + 1) * 4 + h];
    const pg8::f32x4 zero4 = {0.f, 0.f, 0.f, 0.f};
    const bf16x8v ones = {16256, 16256, 16256, 16256, 16256, 16256, 16256, 16256};
    pg8::f32x4 Cown[2] = {zero4, zero4}, nown = zero4; float mst = 0.f;
    for (int round = 0; round < 5; ++round) {
        int lane = lane_in; asm volatile("" : "+v"(lane));
        const int r = lane & 15, g = lane >> 4, q4 = r >> 2, p4 = lane & 3;
        const int n = round * 8 + wave; const bool active = n < 36;
        int rowbase = 0;
        if (n < 4) rowbase = MX + b * TC + (dir ? 3 - n : n) * 64; else rowbase = b * T + (dir ? 35 - n : n - 4) * 64;
        const int rsgn = dir ? -1 : 1, roff = dir ? rowbase + 63 : rowbase;
        const int sw0 = ml_sw(8 * g + q4), sw1 = ml_sw(8 * g + q4 + 4), swr = ml_sw(r);
        bf16x8v qf[4][2], Vf[4][2], kwf[4][2]; pg8::f32x4 O[4][4]; float dl[4] = {0.f, 0.f, 0.f, 0.f}; float fl_own = 0.f, mc_own = 0.f;
        for (int repa = 0; repa < MLREP_A; ++repa) { if (MLREP_A > 1) asm volatile("" : "+v"(lane));
        if (active) {
#pragma unroll
            for (int it = 0; it < 8; ++it) { const int sp = it * 8 + (lane >> 3);
                const v4u x = *(const v4u*)(P + (size_t)(roff + rsgn * sp) * NP + PC_MV + h * 64 + (lane & 7) * 8);
                *(LAS v4u*)(W + ML_V + sp * 128 + (((lane & 7) * 16) ^ ml_sw(sp))) = x; }
            float wk;
            { const size_t rt = (size_t)(roff + rsgn * lane);
              const float ip = (GT[rt * NG + 32 + dir * 8 + h] + gbi) * LOG2E, fp = GT[rt * NG + 32 + dir * 8 + 4 + h] + gbf;
              const float lf = fminf(fp, 0.f) * LOG2E - lg2(1.f + ex2(-fabsf(fp) * LOG2E));
              float x = row_scan_add(lf); const float t0 = lane_bcast(x, 15), t1 = lane_bcast(x, 31), t2 = lane_bcast(x, 47);
              const float cum = x + (g >= 1 ? t0 : 0.f) + (g >= 2 ? t1 : 0.f) + (g >= 3 ? t2 : 0.f);
              const float cl = lane_bcast(cum, 63);
              const float bb = ip - cum;
              float y = row_scan_max(bb); const float m0 = lane_bcast(y, 15), m1 = lane_bcast(y, 31), m2 = lane_bcast(y, 47);
              float cm = -3.0e38f; if (g >= 1) cm = m0; if (g >= 2) cm = fmaxf(cm, m1); if (g >= 3) cm = fmaxf(cm, m2);
              const float pm = fmaxf(y, cm), pm63 = lane_bcast(pm, 63);
              mc_own = cl + pm63; fl_own = cl; wk = ex2(bb - pm63) * 0.125f;
              ((LAS float*)(W + ML_B))[lane] = bb; ((LAS float*)(W + ML_PM))[lane] = pm; ((LAS float*)(W + ML_CUM))[lane] = cum; ((LAS float*)(W + ML_DMX))[lane] = cum + pm; }
            bf16x8v kf[4][2];
#pragma unroll
            for (int i = 0; i < 4; ++i) { const size_t tok = (size_t)(roff + rsgn * (16 * i + r)); const float wki = __shfl(wk, 16 * i + r);
#pragma unroll
                for (int ks = 0; ks < 2; ++ks) { qf[i][ks] = *(const bf16x8v*)(QK + tok * 512 + h * 64 + 32 * ks + 8 * g); kf[i][ks] = *(const bf16x8v*)(QK + tok * 512 + 256 + h * 64 + 32 * ks + 8 * g);
                    const v4u kw4 = __builtin_bit_cast(v4u, kf[i][ks]);
                    float t[8] = {bflo(kw4.x) * wki, bfhi(kw4.x) * wki, bflo(kw4.y) * wki, bfhi(kw4.y) * wki, bflo(kw4.z) * wki, bfhi(kw4.z) * wki, bflo(kw4.w) * wki, bfhi(kw4.w) * wki};
                    *(LAS bf16x8v*)(W + ML_KW + (16 * i + r) * 128 + (((32 * ks + 8 * g) * 2) ^ ml_sw(r))) = pack8(t); } }
#pragma unroll
            for (int dt = 0; dt < 4; ++dt)
#pragma unroll
                for (int ks = 0; ks < 2; ++ks) { LAS unsigned char* a = W + ML_V + (32 * ks + 8 * g + q4) * 128; const int be = (16 * dt + 4 * p4) * 2; Vf[dt][ks] = cat4(tr_read(a + (be ^ sw0)), tr_read(a + 4 * 128 + (be ^ sw1))); }
#pragma unroll
            for (int li = 0; li < 4; ++li) { const float pml = ((const LAS float*)(W + ML_PM))[16 * li + r];
#pragma unroll
                for (int si = 0; si < 4; ++si) { pg8::f32x4 x4 = zero4;
                    if (si <= li) { x4 = MFMA16(kf[si][0], qf[li][0], zero4); x4 = MFMA16(kf[si][1], qf[li][1], x4);
                        const pg8::f32x4 bs = *(const LAS pg8::f32x4*)(W + ML_B + (16 * si + 4 * g) * 4);
#pragma unroll
                        for (int rg = 0; rg < 4; ++rg) { const float v = ex2(bs[rg] - pml) * x4[rg] * 0.125f; x4[rg] = (si < li || r >= 4 * g + rg) ? v : 0.f; } }
                    v2u w; w.x = pg8::cvt_pk_safe(x4[0], x4[1]); w.y = pg8::cvt_pk_safe(x4[2], x4[3]);
                    *(LAS v2u*)(W + ML_SC + r * 144 + (16 * si + 4 * g) * 2) = w; }
                pg8::f32x4 DLt = zero4;
#pragma unroll
                for (int ks = 0; ks < 2; ++ks) { const bf16x8v scf = *(const LAS bf16x8v*)(W + ML_SC + r * 144 + (32 * ks + 8 * g) * 2);
#pragma unroll
                    for (int dt = 0; dt < 4; ++dt) O[dt][li] = MFMA16(Vf[dt][ks], scf, ks == 0 ? zero4 : O[dt][li]);
                    DLt = MFMA16(ones, scf, DLt); }
                dl[li] = DLt[0];
            }
#pragma unroll
            for (int dd = 0; dd < 4; ++dd)
#pragma unroll
                for (int ks = 0; ks < 2; ++ks) { LAS unsigned char* a = W + ML_KW + (32 * ks + 8 * g + q4) * 128; const int be = (16 * dd + 4 * p4) * 2; kwf[dd][ks] = cat4(tr_read(a + (be ^ sw0)), tr_read(a + 4 * 128 + (be ^ sw1))); }
        }
        }
        __syncthreads();
        for (int repb = 0; repb < MLREP_B; ++repb) { if (MLREP_B > 1) asm volatile("" : "+v"(lane));
        if (active) {
#pragma unroll
            for (int dd = 0; dd < 4; ++dd) { pg8::f32x4 Un = MFMA16(kwf[dd][0], ones, zero4); Un = MFMA16(kwf[dd][1], ones, Un);
#pragma unroll
                for (int dt = 0; dt < 4; ++dt) { pg8::f32x4 U = MFMA16(kwf[dd][0], Vf[dt][0], zero4); U = MFMA16(kwf[dd][1], Vf[dt][1], U);
                    v2u w; w.x = pg8::cvt_pk_safe(U[0], U[1]); w.y = pg8::cvt_pk_safe(U[2], U[3]);
                    *(LAS v2u*)(lds + (2 * dd + (dt >> 1)) * WAVE_LDS + ML_V + ((dt & 1) * 8 + wave) * 512 + lane * 8) = w; }
                if (r == 0) *(LAS pg8::f32x4*)(W + ML_B + (16 * dd + 4 * g) * 4) = Un; }
            if (lane == 0) { ((LAS float*)(W + ML_PM))[0] = mc_own; ((LAS float*)(W + ML_PM))[1] = fl_own; }
        }
        }
        __syncthreads();
        float m = 0.f;
        {
            const int odd = wave >> 1, odt = 2 * (wave & 1);
#pragma unroll
            for (int j = 0; j < 8; ++j) if (round * 8 + j < 36) {
                LAS unsigned char* Wj = lds + j * WAVE_LDS;
                const float mcj = ((const LAS float*)(Wj + ML_PM))[0], flj = ((const LAS float*)(Wj + ML_PM))[1];
                const v2u u0 = *(const LAS v2u*)(W + ML_V + j * 512 + lane * 8), u1 = *(const LAS v2u*)(W + ML_V + (8 + j) * 512 + lane * 8);
                const pg8::f32x4 Nj = wave < 4 ? *(const LAS pg8::f32x4*)(Wj + ML_B + (16 * wave + 4 * g) * 4) : zero4;
#pragma unroll
                for (int t = 0; t < 2; ++t) { v2u w; w.x = pg8::cvt_pk_safe(Cown[t][0], Cown[t][1]); w.y = pg8::cvt_pk_safe(Cown[t][2], Cown[t][3]);
                    *(LAS v2u*)(Wj + ML_KW + (16 * (odt + t) + r) * 128 + (((16 * odd + 4 * g) * 2) ^ swr)) = w; }
                if (wave < 4 && r == 0) { v2u w; w.x = pg8::cvt_pk_safe(nown[0], nown[1]); w.y = pg8::cvt_pk_safe(nown[2], nown[3]); *(LAS v2u*)(Wj + ML_N + (16 * wave + 4 * g) * 2) = w; }
                if (j == wave) m = mst;
                const float mn = fmaxf(flj + mst, mcj), a = ex2(flj + mst - mn), gs = ex2(mcj - mn);
                Cown[0] = Cown[0] * a + (pg8::f32x4){bflo(u0.x), bfhi(u0.x), bflo(u0.y), bfhi(u0.y)} * gs; Cown[1] = Cown[1] * a + (pg8::f32x4){bflo(u1.x), bfhi(u1.x), bflo(u1.y), bfhi(u1.y)} * gs; nown = nown * a + Nj * gs; mst = mn; }
        }
        __syncthreads();
        for (int repd = 0; repd < MLREP_D; ++repd) { if (MLREP_D > 1) asm volatile("" : "+v"(lane));
        if (active) {
            bf16x8v nf[2];
#pragma unroll
            for (int ks = 0; ks < 2; ++ks) nf[ks] = *(const LAS bf16x8v*)(W + ML_N + (32 * ks + 8 * g) * 2);
            const bool do_store = (n >= 4 || ctx_out);
#pragma unroll
            for (int li = 0; li < 4; ++li) {
                const float pl = ((const LAS float*)(W + ML_CUM))[16 * li + r] + m, dmx = ((const LAS float*)(W + ML_DMX))[16 * li + r];
                const float mrow = fmaxf(pl, dmx), f1 = ex2(dmx - mrow), f2 = ex2(pl - mrow), cv = ex2(-mrow);
                pg8::f32x4 DI = MFMA16(nf[0], qf[li][0], zero4); DI = MFMA16(nf[1], qf[li][1], DI);
                const float den = f1 * dl[li] + f2 * DI[0];
                const float inv = __builtin_amdgcn_rcpf(fmaxf(fabsf(den), cv));
                bf16* orow = OM + ((size_t)dir * MT + (size_t)(roff + rsgn * (16 * li + r))) * 256 + h * 64 + 4 * g;
#pragma unroll
                for (int dt = 0; dt < 4; ++dt) {
                    const bf16x8v c0 = *(const LAS bf16x8v*)(W + ML_KW + (16 * dt + r) * 128 + (((8 * g) * 2) ^ swr)), c1 = *(const LAS bf16x8v*)(W + ML_KW + (16 * dt + r) * 128 + (((32 + 8 * g) * 2) ^ swr));
                    pg8::f32x4 Tt = MFMA16(c0, qf[li][0], zero4); Tt = MFMA16(c1, qf[li][1], Tt);
                    const pg8::f32x4 o = (O[dt][li] * f1 + Tt * f2) * inv;
                    if (do_store) { v2u w; w.x = pg8::cvt_pk_safe(o[0], o[1]); w.y = pg8::cvt_pk_safe(o[2], o[3]); *(v2u*)(orow + 16 * dt) = w; } }
            }
        }
        }
    }
}


constexpr int SG_STRIDE = 544;
__device__ __forceinline__ void sgu_unit(LAS unsigned char* lds, unsigned char* ws, const bf16* WSG, const float* sb, const int row0, const int tid, const int wave, const int lane) {
    const bf16* P = (const bf16*)(ws + WS_P); bf16* HM = (bf16*)(ws + WS_HM);
    const int r = lane & 15, g = lane >> 4, q4 = r >> 2, p4 = lane & 3, gg = wave >> 1, mh = wave & 1;
    bf16x8v Bf[4][4]; v2u uu[4][4]; float bias[4];
#pragma unroll
    for (int ks = 0; ks < 4; ++ks)
#pragma unroll
        for (int lt = 0; lt < 4; ++lt) Bf[ks][lt] = *(const bf16x8v*)(WSG + ((size_t)gg * 128 + 64 * mh + 16 * lt + r) * 128 + 32 * ks + 8 * g);
#pragma unroll
    for (int lt = 0; lt < 4; ++lt) { const int lpos = 64 * mh + 16 * lt + r; bias[lt] = sb[gg * 128 + lpos];
#pragma unroll
        for (int ct = 0; ct < 4; ++ct) uu[lt][ct] = *(const v2u*)(P + (size_t)(row0 + lpos) * NP + PC_SU + gg * 64 + 16 * ct + 4 * g); }
    {
        const int sp = tid >> 2, qd = tid & 3; const bf16* src = P + (size_t)(row0 + sp) * NP + PC_SV + 64 * qd;
        v4u x[8]; float sum = 0.f;
#pragma unroll
        for (int i = 0; i < 8; ++i) { x[i] = *(const v4u*)(src + 8 * i); sum += (bflo(x[i].x) + bfhi(x[i].x)) + (bflo(x[i].y) + bfhi(x[i].y)) + (bflo(x[i].z) + bfhi(x[i].z)) + (bflo(x[i].w) + bfhi(x[i].w)); }
        sum = quad_sum4(sum);
        const float mu = sum * (1.f / 256.f); float sq = 0.f;
#pragma unroll
        for (int i = 0; i < 8; ++i) { const unsigned ww[4] = {x[i].x, x[i].y, x[i].z, x[i].w};
#pragma unroll
            for (int q = 0; q < 4; ++q) { const float a = bflo(ww[q]) - mu, c = bfhi(ww[q]) - mu; sq += a * a + c * c; } }
        sq = quad_sum4(sq);
        const float rstd = rsqrtf(sq * (1.f / 256.f) + EPS);
#pragma unroll
        for (int i = 0; i < 8; ++i) { const unsigned ww[4] = {x[i].x, x[i].y, x[i].z, x[i].w}; v4u o;
            o.x = pk2((bflo(ww[0]) - mu) * rstd, (bfhi(ww[0]) - mu) * rstd); o.y = pk2((bflo(ww[1]) - mu) * rstd, (bfhi(ww[1]) - mu) * rstd);
            o.z = pk2((bflo(ww[2]) - mu) * rstd, (bfhi(ww[2]) - mu) * rstd); o.w = pk2((bflo(ww[3]) - mu) * rstd, (bfhi(ww[3]) - mu) * rstd);
            *(LAS v4u*)(lds + sp * SG_STRIDE + (64 * qd + 8 * i) * 2) = o; }
    }
    __syncthreads();
    {
        pg8::f32x4 acc[4][4];
#pragma unroll
        for (int ct = 0; ct < 4; ++ct)
#pragma unroll
            for (int lt = 0; lt < 4; ++lt) acc[ct][lt] = (pg8::f32x4){0.f, 0.f, 0.f, 0.f};
#pragma unroll
        for (int ks = 0; ks < 4; ++ks) { bf16x8v Af[4];
#pragma unroll
            for (int ct = 0; ct < 4; ++ct) { LAS unsigned char* a = lds + (32 * ks + 8 * g + q4) * SG_STRIDE + (gg * 64 + 16 * ct + 4 * p4) * 2; Af[ct] = cat4(tr_read(a), tr_read(a + 4 * SG_STRIDE)); }
#pragma unroll
            for (int ct = 0; ct < 4; ++ct)
#pragma unroll
                for (int lt = 0; lt < 4; ++lt) acc[ct][lt] = MFMA16(Af[ct], Bf[ks][lt], acc[ct][lt]); }
#pragma unroll
        for (int lt = 0; lt < 4; ++lt) { const int lpos = 64 * mh + 16 * lt + r; const size_t row = (size_t)(row0 + lpos); const float bs = bias[lt];
#pragma unroll
            for (int ct = 0; ct < 4; ++ct) { const int c = gg * 64 + 16 * ct + 4 * g; const v2u u2 = uu[lt][ct];
                v2u w; w.x = pg8::cvt_pk_safe(bflo(u2.x) * (acc[ct][lt][0] + bs), bfhi(u2.x) * (acc[ct][lt][1] + bs)); w.y = pg8::cvt_pk_safe(bflo(u2.y) * (acc[ct][lt][2] + bs), bfhi(u2.y) * (acc[ct][lt][3] + bs));
                *(v2u*)(HM + row * D + 512 + c) = w; } }
    }
    __syncthreads();
}

template <bool BASEF32> struct EpiRes16 {
    static constexpr bool PERM = true;
    const void* xbase; bf16* xout; const void* cbase; bf16* cout; const float* modl; int goff;
    __device__ __forceinline__ void operator()(const pg8::f32x4 (&acc)[2][2][4][2], const pg8::Unit& u, int wr, int wc, int fr, int fq) const {
        const void* basep; bf16* outp; int bidx; size_t rb;
        if (u.pm < 64) { bidx = u.pm >> 3; rb = (size_t)u.pm * 256; basep = xbase; outp = xout; } else { bidx = 8; rb = (size_t)(u.pm - 64) * 256; basep = cbase; outp = cout; }
        const float* gatep = modl + bidx * 6144 + goff;
        const int col0 = u.pn * 256 + wc * 32 + 8 * fq, r0 = wr * 64 + fr;
        pg8::f32x4 gv[2][2];
#pragma unroll
        for (int bj = 0; bj < 2; ++bj)
#pragma unroll
            for (int n = 0; n < 2; ++n) gv[bj][n] = *(const pg8::f32x4*)(gatep + col0 + bj * 128 + 4 * n);
#pragma unroll
        for (int ai = 0; ai < 2; ++ai)
#pragma unroll
            for (int m = 0; m < 4; ++m) { const size_t off = (rb + r0 + ai * 128 + m * 16) * D + col0;
#pragma unroll
                for (int bj = 0; bj < 2; ++bj) { pg8::f32x4 b0, b1;
                    if (BASEF32) { b0 = __builtin_nontemporal_load((const pg8::f32x4*)((const float*)basep + off + bj * 128)); b1 = __builtin_nontemporal_load((const pg8::f32x4*)((const float*)basep + off + bj * 128 + 4)); }
                    else { const pg8::u32x4 bw = *(const pg8::u32x4*)((const bf16*)basep + off + bj * 128);
                        b0 = (pg8::f32x4){bflo(bw.x), bfhi(bw.x), bflo(bw.y), bfhi(bw.y)}; b1 = (pg8::f32x4){bflo(bw.z), bfhi(bw.z), bflo(bw.w), bfhi(bw.w)}; }
                    const pg8::f32x4 v0 = b0 + gv[bj][0] * acc[ai][bj][m][0], v1 = b1 + gv[bj][1] * acc[ai][bj][m][1];
                    pg8::u32x4 w; w.x = pg8::cvt_pk_bf16(v0[0], v0[1]); w.y = pg8::cvt_pk_bf16(v0[2], v0[3]); w.z = pg8::cvt_pk_bf16(v1[0], v1[1]); w.w = pg8::cvt_pk_bf16(v1[2], v1[3]);
                    *(pg8::u32x4*)(outp + off + bj * 128) = w; } }
    }
};

struct Args { const float* in[25]; float* out; unsigned char* ws; int ph_lo, ph_hi, submask, pad; };

__device__ __forceinline__ void tb_load(f32x4 (&v)[8], const float* W, int ldw, int lane) {
#pragma unroll
    for (int i = 0; i < 8; ++i) v[i] = __builtin_nontemporal_load((const f32x4*)(W + (size_t)(8 * i + (lane >> 3)) * ldw + 4 * (lane & 7)));
}
__device__ __forceinline__ void tb_store(const f32x4 (&v)[8], bf16* dst, int K, LAS float* scr, int lane) {
#pragma unroll
    for (int i = 0; i < 8; ++i) { LAS float* p = scr + (8 * i + (lane >> 3)) * 33 + 4 * (lane & 7); p[0] = v[i].x; p[1] = v[i].y; p[2] = v[i].z; p[3] = v[i].w; }
    LDS_WAIT(); asm volatile("" ::: "memory");
    const int c = lane & 7;
#pragma unroll
    for (int j = 0; j < 4; ++j) { const int n = (lane >> 3) + 8 * j; const LAS float* s = scr + (8 * c) * 33 + n;
        v4u o; o.x = pk2(s[0 * 33], s[1 * 33]); o.y = pk2(s[2 * 33], s[3 * 33]); o.z = pk2(s[4 * 33], s[5 * 33]); o.w = pk2(s[6 * 33], s[7 * 33]);
        __builtin_nontemporal_store(o, (v4u*)(dst + (size_t)n * K + 8 * c)); }
    LDS_WAIT(); asm volatile("" ::: "memory");
}
#define TB_STREAM(DECODE) { int it = lo + widx; const float* src; int ldw; \
    for (; it + 3 * nw < hi; it += 4 * nw) { bf16 *d0, *d1, *d2, *d3; int K0, K1, K2, K3; f32x4 v0[8], v1[8], v2[8], v3[8]; \
        DECODE(it, src, ldw, d0, K0); tb_load(v0, src, ldw, lane); DECODE(it + nw, src, ldw, d1, K1); tb_load(v1, src, ldw, lane); \
        DECODE(it + 2 * nw, src, ldw, d2, K2); tb_load(v2, src, ldw, lane); DECODE(it + 3 * nw, src, ldw, d3, K3); tb_load(v3, src, ldw, lane); \
        tb_store(v0, d0, K0, scr, lane); tb_store(v1, d1, K1, scr, lane); tb_store(v2, d2, K2, scr, lane); tb_store(v3, d3, K3, scr, lane); } \
    for (; it < hi; it += nw) { bf16* d0; int K0; f32x4 v0[8]; DECODE(it, src, ldw, d0, K0); tb_load(v0, src, ldw, lane); tb_store(v0, d0, K0, scr, lane); } }


constexpr int MOE_I_MGU = 16 * 224, MOE_I_MD = 56 * 32, MOE_ITEMS = 8 * MOE_I_MGU + 8 * MOE_I_MD;
__device__ __forceinline__ void moe_convert_range(const int lo, const int hi, const int widx, const int nw, const float* wg, const float* wu, const float* wd, unsigned char* ws, LAS float* scr, const int lane) {
#define MOE_DECODE(IT, SRC, LDW, DST, KK) { int r = (IT); \
        if (r < 8 * MOE_I_MGU) { const int e = r / MOE_I_MGU; r -= e * MOE_I_MGU; const int kb = r / 224, nb = r % 224, r0 = 32 * nb, tile = r0 >> 8, half = (r0 >> 7) & 1, j = r0 & 127; \
            SRC = (half ? wu : wg) + (size_t)e * D * DFE + (size_t)(64 * kb) * DFE + 128 * tile + j; LDW = DFE; \
            DST = (bf16*)(ws + WS_WTMGU) + (size_t)e * 2 * DFE * D + (size_t)r0 * D + 64 * kb; KK = D; } \
        else { r -= 8 * MOE_I_MGU; const int e = r / MOE_I_MD; r -= e * MOE_I_MD; const int kb = r / 32, nb = r % 32; \
            SRC = wd + (size_t)e * DFE * D + (size_t)(64 * kb) * D + 32 * nb; LDW = D; DST = (bf16*)(ws + WS_WTMD) + (size_t)e * D * DFE + (size_t)(32 * nb) * DFE + 64 * kb; KK = DFE; } }
    TB_STREAM(MOE_DECODE)
#undef MOE_DECODE
}

constexpr int DI_IN = 16 * 80, DI_OUT = 16 * 32, DI_GU = 16 * 176, DI_D = 44 * 32, DENSE_ITEMS = 2 * DI_IN + 2 * DI_OUT + DI_GU + DI_D;
__device__ __forceinline__ void dense_convert_range(const int lo, const int hi, const int widx, const int nw, const float* w_in, const float* w_out, const float* wg, const float* wu, const float* wd, unsigned char* ws, LAS float* scr, const int lane) {
#define DENSE_DECODE(IT, SRC, LDW, DST, KK) { int r = (IT); \
        if (r < 2 * DI_IN) { const int l = r / DI_IN; r -= l * DI_IN; const int kb = r / 80, nb = r % 80; const int sc = 32 * nb + (nb >= 24 ? 32 : 0) + (nb >= 56 ? 16 : 0); \
            SRC = w_in + (size_t)l * D * D_IN + (size_t)(64 * kb) * D_IN + sc; LDW = D_IN; DST = (bf16*)(ws + WS_WTIN) + (size_t)l * NPG * D + (size_t)(32 * nb) * D + 64 * kb; KK = D; } \
        else if (r < 2 * DI_IN + 2 * DI_OUT) { r -= 2 * DI_IN; const int l = r / DI_OUT; r -= l * DI_OUT; const int kb = r / 32, nb = r % 32; \
            SRC = w_out + (size_t)l * D * D + (size_t)(64 * kb) * D + 32 * nb; LDW = D; DST = (bf16*)(ws + WS_WTOUT) + (size_t)l * D * D + (size_t)(32 * nb) * D + 64 * kb; KK = D; } \
        else if (r < 2 * DI_IN + 2 * DI_OUT + DI_GU) { r -= 2 * DI_IN + 2 * DI_OUT; const int kb = r / 176, nb = r % 176, r0 = 32 * nb, tile = r0 >> 8, half = (r0 >> 7) & 1, j = r0 & 127; \
            SRC = (half ? wu : wg) + (size_t)(64 * kb) * DFF + 128 * tile + j; LDW = DFF; DST = (bf16*)(ws + WS_WTGU) + (size_t)r0 * D + 64 * kb; KK = D; } \
        else { r -= 2 * DI_IN + 2 * DI_OUT + DI_GU; const int kb = r / 32, nb = r % 32; \
            SRC = wd + (size_t)(64 * kb) * D + 32 * nb; LDW = D; DST = (bf16*)(ws + WS_WTD) + (size_t)(32 * nb) * DFF + 64 * kb; KK = DFF; } }
    TB_STREAM(DENSE_DECODE)
#undef DENSE_DECODE
}
__device__ __forceinline__ void twiddle_step(const int trip, const int t, const float* sw, unsigned char* ws) {
    if (trip < 8) { unsigned* TWX = (unsigned*)(ws + WS_TWX);
#pragma unroll
        for (int q4 = 0; q4 < 4; ++q4) { const int i = (trip * 4 + q4) * 131072 + t, k = i >> 11, tt = (i & 2047) * 2, j0 = (k * (tt & 2047)) & 2047, j1 = (j0 + k) & 2047;
            const float a0 = (float)j0 * (1.f / 2048.f), a1 = (float)j1 * (1.f / 2048.f);
            const float v0 = (tt < 2048 ? __builtin_amdgcn_cosf(a0) : __builtin_amdgcn_sinf(a0)) * 0.0027621358640099515f, v1 = (tt < 2048 ? __builtin_amdgcn_cosf(a1) : __builtin_amdgcn_sinf(a1)) * 0.0027621358640099515f; TWX[i] = pk2(v0, v1); } }
    else { ((bf16*)(ws + WS_WSGU))[t] = (bf16)f2bf(sw[t]);
        if (t < 256 * 256) { unsigned* TWC = (unsigned*)(ws + WS_TWC); const int i = t, k = i >> 8, tt = (i & 255) * 2, j0 = (k * (tt & 255)) & 255, j1 = (j0 + k) & 255;
            const float a0 = (float)j0 * (1.f / 256.f), a1 = (float)j1 * (1.f / 256.f);
            const float v0 = (tt < 256 ? __builtin_amdgcn_cosf(a0) : __builtin_amdgcn_sinf(a0)) * 0.0078125f, v1 = (tt < 256 ? __builtin_amdgcn_cosf(a1) : __builtin_amdgcn_sinf(a1)) * 0.0078125f; TWC[i] = pk2(v0, v1); } }
}

#define AS4 __attribute__((address_space(4)))
typedef const AS4 unsigned char* kptr_t;
__device__ __forceinline__ kptr_t kargs() { kptr_t p = (kptr_t)__builtin_amdgcn_kernarg_segment_ptr(); asm volatile("" : "+s"(p)); return p; }
#define KIN(i) (*(const float* const AS4*)(ka + 8 * (i)))
#define KOUT   (*(float* const AS4*)(ka + 200))
#define KWS    (*(unsigned char* const AS4*)(ka + 208))
#define KLO    (*(const int AS4*)(ka + 216))
#define KHI    (*(const int AS4*)(ka + 220))
#define KSUB   (*(const int AS4*)(ka + 224))
#define PH_BEGIN(k) PH_BEGIN_T(k, 31)
#define PH_BEGIN_T(k, tag) { const kptr_t ka = kargs(); if (KLO <= (k) && (k) < KHI && ((KSUB >> (tag)) & 1)) { unsigned char* const ws = KWS; (void)ws; \
    int tid = threadIdx.x; asm volatile("" : "+v"(tid)); const int lane = tid & 63, wave = __builtin_amdgcn_readfirstlane(tid >> 6), G = gridDim.x, bx = blockIdx.x; \
    const int gw = bx * NWAVES + wave, NGW = G * NWAVES, gtid = bx * (NWAVES * 64) + tid, NGT = G * NWAVES * 64; (void)lane; (void)gw; (void)NGW; (void)gtid; (void)NGT;
#define PH_END } }
#define SEAM(k) { if (MK_ONE_LAUNCH) { const kptr_t ka = kargs(); if (KLO <= (k) && (k) + 1 < KHI) xcd_barrier(bar); } }
#define WSP(T, off) ((T*)(ws + (off)))

template <int l>
__device__ __forceinline__ void layer_phases(LAS unsigned char* lds, const XcdBarrier& bar) {
        const int pb = 1 + l * 16;
        const bool ctx_out = (l == 0);
        PH_BEGIN(pb + 0)
            const float* modl = WSP(float, WS_MOD) + (size_t)l * 9 * 6144;
            const float* ng = KIN(6) + l * D;
            bf16* HM = WSP(bf16, WS_HM);
            const int bq = gw >> 8, wq = gw & 255; f32x4 pa[4], pb[4];
#pragma unroll
            for (int j = 0; j < 4; ++j) { const int c = 4 * lane + 256 * j; const float* mb = modl + bq * 6144; const f32x4 g = *(const f32x4*)(ng + c), sh = *(const f32x4*)(mb + c), sc = *(const f32x4*)(mb + 1024 + c);
                pa[j] = g * (sc + 1.f); pb[j] = sh; }
            for (int trip = 0; trip < 9; ++trip) {
                const int row = trip < 8 ? bq * 2048 + trip * 256 + wq : MX + gw;
                const float* mrow = modl + (row < MX ? (row >> 11) : 8) * 6144;
                f32x4 v[4]; float ss = 0.f;
                if (l == 0) { const float* src = row < MX ? KIN(0) + (size_t)row * D : KIN(2) + (size_t)(row - MX) * D;
#pragma unroll
                    for (int j = 0; j < 4; ++j) v[j] = __builtin_nontemporal_load((const f32x4*)(src + 4 * lane + 256 * j));
                    twiddle_step(trip, gtid, KIN(15), ws); }
                else if (row < MX) { const bf16* src = WSP(bf16, WS_XS16) + (size_t)row * D;
#pragma unroll
                    for (int j = 0; j < 4; ++j) { const v2u w = *(const v2u*)(src + 4 * lane + 256 * j); v[j] = (f32x4){bflo(w.x), bfhi(w.x), bflo(w.y), bfhi(w.y)}; } }
                else { const size_t rc = (size_t)(row - MX); const bf16* src = WSP(bf16, WS_XC) + rc * D; const bf16* p0 = WSP(bf16, WS_CPART) + rc * D; const bf16* p1 = p0 + (size_t)MC * D; const float* g2p = WSP(float, WS_MOD) + 8 * 6144 + 5120;
#pragma unroll
                    for (int j = 0; j < 4; ++j) { const int c = 4 * lane + 256 * j; const v2u w = *(const v2u*)(src + c), a = *(const v2u*)(p0 + c), b2 = *(const v2u*)(p1 + c); const f32x4 g2 = *(const f32x4*)(g2p + c);
                        v[j] = (f32x4){bflo(w.x) + g2.x * (bflo(a.x) + bflo(b2.x)), bfhi(w.x) + g2.y * (bfhi(a.x) + bfhi(b2.x)), bflo(w.y) + g2.z * (bflo(a.y) + bflo(b2.y)), bfhi(w.y) + g2.w * (bfhi(a.y) + bfhi(b2.y))}; } }
#pragma unroll
                for (int j = 0; j < 4; ++j) ss += (v[j].x * v[j].x + v[j].y * v[j].y) + (v[j].z * v[j].z + v[j].w * v[j].w);
                const float rstd = rsqrtf(wave_sum(ss) * (1.f / D) + EPS);
#pragma unroll
                for (int j = 0; j < 4; ++j) { const int c = 4 * lane + 256 * j;
                    if (trip < 8) v[j] = v[j] * rstd * pa[j] + pb[j];
                    else { const f32x4 g = *(const f32x4*)(ng + c), sh = *(const f32x4*)(mrow + c), sc = *(const f32x4*)(mrow + 1024 + c); v[j] = v[j] * rstd * (g * (sc + 1.f)) + sh; }
                    v2u o; o.x = pk2(v[j].x, v[j].y); o.y = pk2(v[j].z, v[j].w); *(v2u*)(HM + (size_t)row * D + c) = o; }
            }
        PH_END
        SEAM(pb + 0)
        PH_BEGIN(pb + 1)
            constexpr int GG = (l == 0) ? 200 : 256;
            if (bx < GG) {
            InProjSched S; S.init(WSP(bf16, WS_HM), WSP(bf16, WS_WTIN) + (size_t)l * NPG * D, l == 0 ? 11 : 8, GG, bx);
            EpiInProj E{WSP(bf16, WS_P), WSP(float, WS_G)};
            pg8::gemm_phase<EpiInProj, InProjSched, PG8_ALIGN, PG8_SP2>(lds, D, S, E);
            }
        PH_END
        PH_BEGIN_T(pb + 1, 5)
            if (l == 0 && bx >= 200) {
                dense_convert_range(DI_IN, DENSE_ITEMS, (bx - 200) * 8 + wave, 56 * 8, KIN(8), KIN(9), KIN(17), KIN(18), KIN(19), ws, (LAS float*)(lds + wave * 16384), lane);
                moe_convert_range(0, 1500, (bx - 200) * 8 + wave, 56 * 8, KIN(21), KIN(22), KIN(23), ws, (LAS float*)(lds + wave * 16384), lane); }
        PH_END
        SEAM(pb + 1)
        PH_BEGIN(pb + 2)
            const bf16* P = WSP(bf16, WS_P); bf16* QK = WSP(bf16, WS_QK);
            const float* cw = KIN(13) + l * 9 * 512;
            f32x4 w0[9], w1[9];
            { const int ch = (gtid & 63) * 8;
#pragma unroll
              for (int tp = 0; tp < 9; ++tp) { w0[tp] = *(const f32x4*)(cw + tp * 512 + ch); w1[tp] = *(const f32x4*)(cw + tp * 512 + ch + 4); } }
            for (int rowv = gw; rowv < MT; rowv += NGW) {
                const int row = __builtin_amdgcn_readfirstlane(rowv), ch = lane * 8;
                int base, rr0, cc0, nr, nc;
                if (row < MX) { base = (row >> 11) * T; const int t = row & 2047; rr0 = t >> 6; cc0 = t & 63; nr = 32; nc = 64; }
                else { const int rc = row - MX; base = MX + (rc >> 8) * TC; rr0 = 0; cc0 = rc & 255; nr = 1; nc = 256; }
                v4u x[9]; bool ok[9];
#pragma unroll
                for (int dr = -1; dr <= 1; ++dr)
#pragma unroll
                    for (int dc = -1; dc <= 1; ++dc) { const int rr = rr0 + dr, cc = cc0 + dc, tp = (dr + 1) * 3 + (dc + 1); ok[tp] = (unsigned)rr < (unsigned)nr && (unsigned)cc < (unsigned)nc;
                        x[tp] = *(const v4u*)(P + (size_t)(base + (ok[tp] ? rr : rr0) * nc + (ok[tp] ? cc : cc0)) * NP + PC_MQ + ch); }
                float y[8];
#pragma unroll
                for (int j = 0; j < 8; ++j) y[j] = 0.f;
#pragma unroll
                for (int tp = 0; tp < 9; ++tp) if (ok[tp]) { y[0] += bflo(x[tp].x) * w0[tp].x; y[1] += bfhi(x[tp].x) * w0[tp].y; y[2] += bflo(x[tp].y) * w0[tp].z; y[3] += bfhi(x[tp].y) * w0[tp].w;
                    y[4] += bflo(x[tp].z) * w1[tp].x; y[5] += bfhi(x[tp].z) * w1[tp].y; y[6] += bflo(x[tp].w) * w1[tp].z; y[7] += bfhi(x[tp].w) * w1[tp].w; }
                v4u o; o.x = pk2(siluf_(y[0]), siluf_(y[1])); o.y = pk2(siluf_(y[2]), siluf_(y[3])); o.z = pk2(siluf_(y[4]), siluf_(y[5])); o.w = pk2(siluf_(y[6]), siluf_(y[7]));
                *(v4u*)(QK + (size_t)row * 512 + ch) = o;
            }
        PH_END
        PH_BEGIN(pb + 2)
            const bf16* P = WSP(bf16, WS_P); const bf16* TWCH = WSP(bf16, WS_TWCH);
            const int r = lane & 15, g = lane >> 4; LAS unsigned char* W = lds + wave * WAVE_LDS;
            const int nitems = ctx_out ? (MT / 64) * 4 : (MX / 64) * 4;
            for (int it = wave * G + bx; it < nitems; it += NGW) {
                const int blk = it >> 2, gg = it & 3, row0 = blk * 64;
                bf16* fb; int Tn, t0;
                if (row0 < MX) { const int b = row0 >> 11; t0 = row0 & 2047; Tn = T; fb = WSP(bf16, WS_FBX) + ((size_t)b * 256 + gg * 64) * 4096; }
                else { const int rc = row0 - MX, b = rc >> 8; t0 = rc & 255; Tn = TC; fb = WSP(bf16, WS_FBC) + ((size_t)b * 256 + gg * 64) * 512; }
                bf16x8v Af[4][2];
#pragma unroll
                for (int i = 0; i < 4; ++i)
#pragma unroll
                    for (int ks = 0; ks < 2; ++ks) Af[i][ks] = *(const bf16x8v*)(P + (size_t)(row0 + 16 * i + r) * NP + PC_F + gg * 64 + 32 * ks + 8 * g);
#pragma unroll
                for (int nt = 0; nt < 8; ++nt) { const bf16x8v b0 = *(const bf16x8v*)(TWCH + (16 * nt + r) * 64 + 8 * g), b1 = *(const bf16x8v*)(TWCH + (16 * nt + r) * 64 + 32 + 8 * g);
#pragma unroll
                    for (int i = 0; i < 4; ++i) { pg8::f32x4 d = MFMA16(Af[i][0], b0, ((pg8::f32x4){0.f, 0.f, 0.f, 0.f})); d = MFMA16(Af[i][1], b1, d);
                        v2u w; w.x = pg8::cvt_pk_safe(d[0], d[1]); w.y = pg8::cvt_pk_safe(d[2], d[3]); *(LAS v2u*)(W + (16 * nt + r) * 144 + (16 * i + 4 * g) * 2) = w; } }
#pragma unroll
                for (int j = 0; j < 16; ++j) { const int np = j * 8 + (lane >> 3); const v4u x = *(const LAS v4u*)(W + np * 144 + (lane & 7) * 16);
                    *(v4u*)(fb + (size_t)(np & 63) * (2 * Tn) + (np >= 64 ? Tn : 0) + t0 + (lane & 7) * 8) = x; }
            }
        PH_END
        SEAM(pb + 2)
        PH_BEGIN_T(pb + 3, 0)
            if (bx < 64) gla_scan<l>(lds, ws, KIN(10), KIN(11), bx, wave, lane, ctx_out);
        PH_END
        PH_BEGIN_T(pb + 3, 1)
            if (bx >= 64 && bx < 128) mlstm_scan<l>(lds, ws, KIN(14), bx - 64, wave, lane, ctx_out);
        PH_END
        PH_BEGIN_T(pb + 3, 2)
            if (bx >= 128) {
                const bf16* WSG = WSP(bf16, WS_WSGU) + (size_t)l * 4 * 128 * 128; const float* sb = KIN(16) + l * 4 * 128;
                sgu_unit(lds, ws, WSG, sb, (bx - 128) * 128, tid, wave, lane);
                if (ctx_out && bx < 144) sgu_unit(lds, ws, WSG, sb, MX + (bx - 128) * 128, tid, wave, lane);
            }
        PH_END
        PH_BEGIN_T(pb + 3, 3)
            FourierSymSched S{(const char*)WSP(bf16, WS_TWX), (const char*)WSP(bf16, WS_FBX), G, bx - 128};
            EpiFourierSym E{WSP(bf16, WS_PQ)};
            pg8::gemm_phase<EpiFourierSym, FourierSymSched, PG8_ALIGN, PG8_SP2>(lds, 1024, S, E, 4096);
        PH_END
        PH_BEGIN_T(pb + 3, 3)
            if (bx >= 128) {
                const bf16* FBX = WSP(bf16, WS_FBX); bf16* PQ = WSP(bf16, WS_PQ);
#pragma unroll
                for (int j = 0; j < 2; ++j) { const int idx = ((bx - 128) * 8 + wave) * 2 + j; const bf16* src = FBX + (size_t)idx * 4096 + 8 * lane; float sacc = 0.f;
#pragma unroll
                    for (int q = 0; q < 4; ++q) { const v4u xv = *(const v4u*)(src + 512 * q);
                        sacc += (bflo(xv.x) - bfhi(xv.x)) + (bflo(xv.y) - bfhi(xv.y)) + (bflo(xv.z) - bfhi(xv.z)) + (bflo(xv.w) - bfhi(xv.w)); }
                    sacc = wave_sum(sacc);
                    if (lane < 4) PQ[((size_t)(lane * 8 + (idx >> 8)) * PQ_ROWS + 1024) * 256 + (idx & 255)] = lane == 0 ? (bf16)f2bf(sacc * 0.0027621358640099515f) : (bf16)0; } }
        PH_END
        if (ctx_out) {
        PH_BEGIN_T(pb + 3, 4)
            BatchSched S{(const char*)WSP(bf16, WS_TWC), (const char*)WSP(bf16, WS_FBC), (size_t)256 * 512 * 2, (size_t)256 * 512 * 2, (size_t)256 * 2, 16, 1, G, bx >= 128 ? 255 - bx : -1};
            EpiFourier E{WSP(bf16, WS_HM) + (size_t)MX * D + 768, D, (size_t)TC * D, WSP(bf16, WS_MIXB) + (size_t)MX * 256, 256, (size_t)TC * 256};
            int kc = 256; asm volatile("" : "+s"(kc));
            pg8::gemm_phase<EpiFourier, BatchSched, PG8_ALIGN, PG8_SP2>(lds, kc, S, E, 512);
        PH_END
        }
        PH_BEGIN(pb + 3)
            if (l == 0) { if (bx >= 144) { moe_convert_range(35500, 39000, (bx - 144) * 8 + wave, 112 * 8, KIN(21), KIN(22), KIN(23), ws, (LAS float*)(lds + wave * 16384), lane);
                    moe_convert_range(1500, 4500, (bx - 144) * 8 + wave, 112 * 8, KIN(21), KIN(22), KIN(23), ws, (LAS float*)(lds + wave * 16384), lane); } }
            else if (bx >= 128) moe_convert_range(39000, MOE_ITEMS, (bx - 128) * 8 + wave, 128 * 8, KIN(21), KIN(22), KIN(23), ws, (LAS float*)(lds + wave * 16384), lane);
        PH_END
        SEAM(pb + 3)
        PH_BEGIN(pb + 4)
            const bf16* P = WSP(bf16, WS_P); const bf16* OG = WSP(bf16, WS_OG); const bf16* OM = WSP(bf16, WS_OM); bf16* HM = WSP(bf16, WS_HM); const bf16* MIXB = WSP(bf16, WS_MIXB);
            const float* gng = KIN(12) + l * 256;
            constexpr int NB = (l == 0) ? 3 : 4, NIT = (l == 0) ? 3 : 2;
            const int c = 4 * lane; const f32x4 ng = *(const f32x4*)(gng + c);
            for (int it = 0; it < NIT; ++it) {
                v2u of[NB], ob[NB], gg[NB], hf[NB], hb[NB], og[NB], fa[NB], fb[NB], fc[NB], fd[NB];
#pragma unroll
                for (int k = 0; k < NB; ++k) { const size_t row = (size_t)(gw + (it * NB + k) * NGW);
                    of[k] = __builtin_nontemporal_load((const v2u*)(OG + row * 256 + c)); ob[k] = __builtin_nontemporal_load((const v2u*)(OG + ((size_t)MT + row) * 256 + c));
                    hf[k] = __builtin_nontemporal_load((const v2u*)(OM + row * 256 + c)); hb[k] = __builtin_nontemporal_load((const v2u*)(OM + ((size_t)MT + row) * 256 + c));
                    gg[k] = *(const v2u*)(P + row * NP + PC_GG + c); og[k] = *(const v2u*)(P + row * NP + PC_MO + c);
                    {
                        const bool isx = it * NB + k < 8; const int t = (int)row & 2047, kk = t <= 1024 ? t : 2048 - t;
                        const bf16* pq = WSP(bf16, WS_PQ) + ((size_t)((int)row >> 11) * PQ_ROWS + kk) * 256 + c; const bf16* cb = MIXB + row * 256 + c;
                        const bf16* pa = isx ? pq : HM + row * D + 768 + c; const bf16* pb = isx ? pq + (size_t)8 * PQ_ROWS * 256 : cb;
                        const bf16* pc = isx ? pq + (size_t)2 * 8 * PQ_ROWS * 256 : cb; const bf16* pd = isx ? pq + (size_t)3 * 8 * PQ_ROWS * 256 : cb;
                        fa[k] = *(const v2u*)pa; fb[k] = *(const v2u*)pb; fc[k] = *(const v2u*)pc; fd[k] = *(const v2u*)pd; } }
#pragma unroll
                for (int k = 0; k < NB; ++k) { const size_t row = (size_t)(gw + (it * NB + k) * NGW);
                    const float o0 = bflo(of[k].x) + bflo(ob[k].x), o1 = bfhi(of[k].x) + bfhi(ob[k].x), o2 = bflo(of[k].y) + bflo(ob[k].y), o3 = bfhi(of[k].y) + bfhi(ob[k].y);
                    float ss = (o0 * o0 + o1 * o1) + (o2 * o2 + o3 * o3);
                    ss = row_sum16(ss);
                    const float rs = rsqrtf(ss * (1.f / 64.f) + EPS);
                    v2u w; w.x = pk2(o0 * rs * ng.x * siluf_(bflo(gg[k].x)), o1 * rs * ng.y * siluf_(bfhi(gg[k].x))); w.y = pk2(o2 * rs * ng.z * siluf_(bflo(gg[k].y)), o3 * rs * ng.w * siluf_(bfhi(gg[k].y)));
                    *(v2u*)(HM + row * D + c) = w;
                    v2u w2; w2.x = pk2(sigmoidf_(bflo(og[k].x)) * (bflo(hf[k].x) + bflo(hb[k].x)), sigmoidf_(bfhi(og[k].x)) * (bfhi(hf[k].x) + bfhi(hb[k].x)));
                    w2.y = pk2(sigmoidf_(bflo(og[k].y)) * (bflo(hf[k].y) + bflo(hb[k].y)), sigmoidf_(bfhi(og[k].y)) * (bfhi(hf[k].y) + bfhi(hb[k].y)));
                    *(v2u*)(HM + row * D + 256 + c) = w2;
                    const int tt = (int)row & 2047; const float sg = (it * NB + k < 8) ? (tt > 1024 ? -1.f : 1.f) : 0.f;
                    f32x4 fo = {(bflo(fa[k].x) + bflo(fb[k].x)) + sg * (bflo(fc[k].x) + bflo(fd[k].x)), (bfhi(fa[k].x) + bfhi(fb[k].x)) + sg * (bfhi(fc[k].x) + bfhi(fd[k].x)),
                                (bflo(fa[k].y) + bflo(fb[k].y)) + sg * (bflo(fc[k].y) + bflo(fd[k].y)), (bfhi(fa[k].y) + bfhi(fb[k].y)) + sg * (bfhi(fc[k].y) + bfhi(fd[k].y))};
                    v2u w3; w3.x = pk2(fo.x, fo.y); w3.y = pk2(fo.z, fo.w); *(v2u*)(HM + row * D + 768 + c) = w3; }
            }
        PH_END
        SEAM(pb + 4)
        PH_BEGIN(pb + 5)
            DenseSched S; S.init(WSP(bf16, WS_HM), WSP(bf16, WS_WTOUT) + (size_t)l * D * D, MX / 256, D / 256, D, G, bx);
            if (l == 0) { EpiRes16<true> E{KIN(0), WSP(bf16, WS_XS16), KIN(2), WSP(bf16, WS_XC), WSP(float, WS_MOD), 2048};
                pg8::gemm_phase<EpiRes16<true>, DenseSched, PG8_ALIGN, PG8_SP2>(lds, D, S, E);
                CtxSplit4Sched S2{(const char*)(WSP(bf16, WS_HM) + (size_t)MX * D), (const char*)WSP(bf16, WS_WTOUT), (size_t)256 * D * 2, (size_t)256 * 2, G, (bx + 128) & 255};
                EpiKSplit E2{WSP(bf16, WS_CPART), (size_t)MC * D};
                int kc = 256; asm volatile("" : "+s"(kc));
                pg8::gemm_phase<EpiKSplit, CtxSplit4Sched, PG8_ALIGN, PG8_SP2>(lds, kc, S2, E2, D); }
            else { EpiRes16<false> E{WSP(bf16, WS_XS16), WSP(bf16, WS_XS16), WSP(bf16, WS_XC), WSP(bf16, WS_XC), WSP(float, WS_MOD) + (size_t)9 * 6144, 2048};
                pg8::gemm_phase<EpiRes16<false>, DenseSched, PG8_ALIGN, PG8_SP2>(lds, D, S, E); }
        PH_END
        PH_BEGIN(pb + 5)
            if (l == 0 && bx < 128) moe_convert_range(4500, 8500, bx * 8 + wave, 128 * 8, KIN(21), KIN(22), KIN(23), ws, (LAS float*)(lds + wave * 16384), lane);
        PH_END
        SEAM(pb + 5)
        PH_BEGIN(pb + 6)
            const bf16* xs = WSP(bf16, WS_XS16); const bf16* XC = WSP(bf16, WS_XC); const float* modl = WSP(float, WS_MOD) + (size_t)l * 9 * 6144; bf16* HM = WSP(bf16, WS_HM);
            const float* ng = KIN(7) + l * D; const float* moe_router = KIN(20);
            float* RG = WSP(float, WS_ROUTE + 65536); int* RE = WSP(int, WS_ROUTE); int* RP = WSP(int, WS_ROUTE + 65536 * 3);
            LAS int* lcnt = (LAS int*)lds; LAS int* wgb = lcnt + 8; LAS int* rinfo = lcnt + 16;
            if (l == 1) { if (tid < 16) lcnt[tid] = 0; __syncthreads(); }
            const int nrows = ctx_out ? MT : MX, rpw = nrows / NGW;
            const int bq = gw >> 8, wq = gw & 255; f32x4 pa[4], pb[4];
#pragma unroll
            for (int j = 0; j < 4; ++j) { const int c = 4 * lane + 256 * j; const float* mb = modl + bq * 6144; const f32x4 g = *(const f32x4*)(ng + c), sh = *(const f32x4*)(mb + 3072 + c), sc = *(const f32x4*)(mb + 4096 + c);
                pa[j] = g * (sc + 1.f); pb[j] = sh; }
            f32x4 rw0[16], rw1[16];
            if (l == 1) {
#pragma unroll
                for (int j = 0; j < 4; ++j)
#pragma unroll
                    for (int q = 0; q < 4; ++q) { const float* wr_ = moe_router + (size_t)(4 * lane + 256 * j + q) * 8; rw0[j * 4 + q] = *(const f32x4*)wr_; rw1[j * 4 + q] = *(const f32x4*)(wr_ + 4); } }
            for (int ri = 0; ri < rpw; ++ri) {
                const int row = ri < 8 ? bq * 2048 + ri * 256 + wq : gw + 8 * NGW;
                const float* mrow = modl + (row < MX ? (row >> 11) : 8) * 6144;
                f32x4 v[4]; float ss = 0.f;
                if (row < MX) { const bf16* src = xs + (size_t)row * D;
#pragma unroll
                    for (int j = 0; j < 4; ++j) { const v2u w = *(const v2u*)(src + 4 * lane + 256 * j); v[j] = (f32x4){bflo(w.x), bfhi(w.x), bflo(w.y), bfhi(w.y)}; } }
                else { const size_t rc = (size_t)(row - MX); const float* cin = KIN(2) + rc * D; const bf16* p0 = WSP(bf16, WS_CPART) + rc * D; const bf16* p1 = p0 + (size_t)MC * D; bf16* xcw = WSP(bf16, WS_XC) + rc * D;
#pragma unroll
                    for (int j = 0; j < 4; ++j) { const int c = 4 * lane + 256 * j; const v2u a = *(const v2u*)(p0 + c), b2 = *(const v2u*)(p1 + c), a3 = *(const v2u*)(p1 + (size_t)MC * D + c), a4 = *(const v2u*)(p1 + (size_t)2 * MC * D + c);
                        const f32x4 g1 = *(const f32x4*)(mrow + 2048 + c), ci = *(const f32x4*)(cin + c);
                        const f32x4 pp = {(bflo(a.x) + bflo(b2.x)) + (bflo(a3.x) + bflo(a4.x)), (bfhi(a.x) + bfhi(b2.x)) + (bfhi(a3.x) + bfhi(a4.x)), (bflo(a.y) + bflo(b2.y)) + (bflo(a3.y) + bflo(a4.y)), (bfhi(a.y) + bfhi(b2.y)) + (bfhi(a3.y) + bfhi(a4.y))};
                        v2u o; o.x = pk2(ci.x + g1.x * pp.x, ci.y + g1.y * pp.y); o.y = pk2(ci.z + g1.z * pp.z, ci.w + g1.w * pp.w); *(v2u*)(xcw + c) = o;
                        v[j] = (f32x4){bflo(o.x), bfhi(o.x), bflo(o.y), bfhi(o.y)}; } }
#pragma unroll
                for (int j = 0; j < 4; ++j) ss += (v[j].x * v[j].x + v[j].y * v[j].y) + (v[j].z * v[j].z + v[j].w * v[j].w);
                const float rstd = rsqrtf(wave_sum(ss) * (1.f / D) + EPS);
#pragma unroll
                for (int j = 0; j < 4; ++j) { const int c = 4 * lane + 256 * j;
                    if (ri < 8) v[j] = v[j] * rstd * pa[j] + pb[j];
                    else { const f32x4 g = *(const f32x4*)(ng + c), sh = *(const f32x4*)(mrow + 3072 + c), sc = *(const f32x4*)(mrow + 4096 + c); v[j] = v[j] * rstd * (g * (sc + 1.f)) + sh; }
                    v2u o; o.x = pk2(v[j].x, v[j].y); o.y = pk2(v[j].z, v[j].w); *(v2u*)(HM + (size_t)row * D + c) = o; }
                if (l == 1) {
                    float lg[8];
#pragma unroll
                    for (int e = 0; e < 8; ++e) lg[e] = 0.f;
#pragma unroll
                    for (int j = 0; j < 4; ++j) { const float vv[4] = {v[j].x, v[j].y, v[j].z, v[j].w};
#pragma unroll
                        for (int q = 0; q < 4; ++q) { const f32x4 w0 = rw0[j * 4 + q], w1 = rw1[j * 4 + q];
                            lg[0] += vv[q] * w0.x; lg[1] += vv[q] * w0.y; lg[2] += vv[q] * w0.z; lg[3] += vv[q] * w0.w; lg[4] += vv[q] * w1.x; lg[5] += vv[q] * w1.y; lg[6] += vv[q] * w1.z; lg[7] += vv[q] * w1.w; } }
#pragma unroll
                    for (int e = 0; e < 8; ++e) lg[e] = wave_sum(lg[e]);
                    float v0 = lg[0]; int e0 = 0;
#pragma unroll
                    for (int e = 1; e < 8; ++e) if (lg[e] > v0) { v0 = lg[e]; e0 = e; }
                    float v1 = -3.0e38f; int e1 = 0;
#pragma unroll
                    for (int e = 0; e < 8; ++e) if (e != e0 && lg[e] > v1) { v1 = lg[e]; e1 = e; }
                    if (lane == 0) { const float g0 = 1.f / (1.f + __expf(v1 - v0));
                        RG[row * 2] = g0; RG[row * 2 + 1] = 1.f - g0;
                        const int lp0 = __hip_atomic_fetch_add(&lcnt[e0], 1, __ATOMIC_RELAXED, __HIP_MEMORY_SCOPE_WORKGROUP);
                        const int lp1 = __hip_atomic_fetch_add(&lcnt[e1], 1, __ATOMIC_RELAXED, __HIP_MEMORY_SCOPE_WORKGROUP);
                        const int lr = wave * rpw + ri; rinfo[lr * 4] = e0; rinfo[lr * 4 + 1] = e1; rinfo[lr * 4 + 2] = lp0; rinfo[lr * 4 + 3] = lp1; }
                }
            }
            if (l == 1) {
                __syncthreads();
                if (tid < 8) wgb[tid] = (int)__hip_atomic_fetch_add((unsigned*)(ws + WS_CTL) + CW_CNT + tid * 64, (unsigned)lcnt[tid], RLX_AGENT);
                __syncthreads();
                if (tid < 64) { const int gwq = bx * 8 + (tid >> 3); const int row = (gwq >> 8) * 2048 + (tid & 7) * 256 + (gwq & 255); const int e0 = rinfo[tid * 4], e1 = rinfo[tid * 4 + 1];
                    const int p0 = wgb[e0] + rinfo[tid * 4 + 2], p1 = wgb[e1] + rinfo[tid * 4 + 3]; int* LIST = WSP(int, WS_ROUTE + 65536 * 8);
                    RE[row] = e0 | (e1 << 8); RP[row * 2] = p0; RP[row * 2 + 1] = p1; LIST[e0 * MX + p0] = row; LIST[e1 * MX + p1] = row; }
                __syncthreads();
            }
        PH_END
        SEAM(pb + 6)
        if (l == 0) {
            PH_BEGIN(pb + 7)
                if (bx < 232) {
                DenseSched S; S.init(WSP(bf16, WS_HM), WSP(bf16, WS_WTGU), MT / 256, 2 * DFF / 256, D, 232, bx);
                EpiSwiGLU E{WSP(bf16, WS_ACTF), DFF};
                pg8::gemm_phase<EpiSwiGLU, DenseSched, PG8_ALIGN, PG8_SP2>(lds, D, S, E);
                }
            PH_END
            PH_BEGIN_T(pb + 7, 5)
                if (bx >= 232) moe_convert_range(8500, 20500, (bx - 232) * 8 + wave, 24 * 8, KIN(21), KIN(22), KIN(23), ws, (LAS float*)(lds + wave * 16384), lane);
            PH_END
            SEAM(pb + 7)
            PH_BEGIN(pb + 8)
                DenseSched S; S.init(WSP(bf16, WS_ACTF), WSP(bf16, WS_WTD), MX / 256, D / 256, DFF, G, bx);
                EpiRes16<false> E{WSP(bf16, WS_XS16), WSP(bf16, WS_XS16), WSP(bf16, WS_XC), WSP(bf16, WS_XC), WSP(float, WS_MOD), 5120};
                pg8::gemm_phase<EpiRes16<false>, DenseSched, PG8_ALIGN, PG8_SP2>(lds, DFF, S, E);
                CtxSplitSched S2{(const char*)(WSP(bf16, WS_ACTF) + (size_t)MX * DFF), (const char*)WSP(bf16, WS_WTD), (size_t)256 * DFF * 2, (size_t)1408 * 2, G, (bx + 128) & 255};
                EpiKSplit E2{WSP(bf16, WS_CPART), (size_t)MC * D};
                pg8::gemm_phase<EpiKSplit, CtxSplitSched, PG8_ALIGN, PG8_SP2>(lds, 1408, S2, E2, DFF);
            PH_END
            PH_BEGIN(pb + 8)
                if (bx < 128 || bx >= 192) moe_convert_range(20500, 35500, (bx < 128 ? bx : bx - 64) * 8 + wave, 192 * 8, KIN(21), KIN(22), KIN(23), ws, (LAS float*)(lds + wave * 16384), lane);
            PH_END
            SEAM(pb + 8)
        } else {
#pragma unroll
            for (int ps = 0; ps < 2; ++ps) {
                PH_BEGIN(pb + 8 + 2 * ps)
                    MoeGatherSched S; S.W = (const char*)(ws + WS_WTMGU); S.tstepW = (size_t)256 * D * 2; S.estride = (size_t)2 * DFE * D * 2; S.LIST = WSP(int, WS_ROUTE + 65536 * 8);
                    { int a0 = 0;
#pragma unroll
                      for (int e = 0; e < 8; ++e) { S.cnt[e] = (int)__builtin_amdgcn_readfirstlane(__hip_atomic_load((unsigned*)(ws + WS_CTL) + CW_CNT + e * 64, RLX_AGENT)); S.tb[e] = a0; a0 += (S.cnt[e] + 255) >> 8; }
                      S.tb[8] = a0; }
                    S.t0 = MOE_PASS * ps; int nt = S.tb[8] - S.t0; if (ps == 0) nt = nt > MOE_PASS ? MOE_PASS : nt;
                    if (nt > 0) {
                        S.A = (const char*)(ws + WS_HM); S.o.init(nt, 2 * DFE / 256, G, bx);
                        EpiSwiGLU E{WSP(bf16, WS_ACTM), DFE};
                        pg8::gemm_phase<EpiSwiGLU, MoeGatherSched, PG8_ALIGN, PG8_SP2, true>(lds, D, S, E);
                    }
                PH_END
                SEAM(pb + 8 + 2 * ps)
                PH_BEGIN(pb + 9 + 2 * ps)
                    MoeSched S; S.A = (const char*)(ws + WS_ACTM); S.W = (const char*)(ws + WS_WTMD); S.tstepA = (size_t)256 * DFE * 2; S.tstepW = (size_t)256 * DFE * 2; S.estride = (size_t)D * DFE * 2;
                    { int a0 = 0;
#pragma unroll
                      for (int e = 0; e < 8; ++e) { S.tb[e] = a0; a0 += ((int)__builtin_amdgcn_readfirstlane(__hip_atomic_load((unsigned*)(ws + WS_CTL) + CW_CNT + e * 64, RLX_AGENT)) + 255) >> 8; }
                      S.tb[8] = a0; }
                    S.t0 = MOE_PASS * ps; int nt = S.tb[8] - S.t0; nt = nt > MOE_PASS ? MOE_PASS : nt;
                    if (nt > 0) {
                        S.o.init(nt, D / 256, G, bx);
                        EpiBf16Plain E{WSP(bf16, WS_XS) + (size_t)S.t0 * 256 * D, D, 0};
                        pg8::gemm_phase<EpiBf16Plain, MoeSched, PG8_ALIGN, PG8_SP2>(lds, DFE, S, E);
                    }
                PH_END
                if (ps == 1) {
                PH_BEGIN(pb + 9 + 2 * ps)
                    KSplitSched S; S.A = (const char*)(ws + WS_ACTM) + (size_t)64 * 256 * DFE * 2; S.W = (const char*)(ws + WS_WTMD); S.tstepA = (size_t)256 * DFE * 2; S.tstepW = (size_t)256 * DFE * 2; S.estride = (size_t)D * DFE * 2;
                    { int a0 = 0;
#pragma unroll
                      for (int e = 0; e < 8; ++e) { S.tb[e] = a0; a0 += ((int)__builtin_amdgcn_readfirstlane(__hip_atomic_load((unsigned*)(ws + WS_CTL) + CW_CNT + e * 64, RLX_AGENT)) + 255) >> 8; }
                      S.tb[8] = a0; }
                    const int nleft = S.tb[8] - 128;
                    if (nleft > 0) {
                        S.nunits = nleft * 28; S.G = G; S.c = (bx + 128) & 255;
                        EpiKSplit E{WSP(bf16, WS_YLP), (size_t)8 * 256 * D};
                        pg8::gemm_phase<EpiKSplit, KSplitSched, PG8_ALIGN, PG8_SP2>(lds, 512, S, E, DFE);
                    }
                PH_END
                }
                SEAM(pb + 9 + 2 * ps)
            }
            PH_BEGIN(pb + 14)
                float* xs = KOUT; const bf16* XS16 = WSP(bf16, WS_XS16); const float* modl = WSP(float, WS_MOD) + (size_t)9 * 6144; const float* final_norm_g = KIN(24);
                const int* RE = WSP(int, WS_ROUTE); const int* RP = WSP(int, WS_ROUTE + 65536 * 3); const float* RG = WSP(float, WS_ROUTE + 65536);
                int tbA[8];
                { int a0 = 0;
#pragma unroll
                  for (int e = 0; e < 8; ++e) { tbA[e] = a0; a0 += ((int)__builtin_amdgcn_readfirstlane(__hip_atomic_load((unsigned*)(ws + WS_CTL) + CW_CNT + e * 64, RLX_AGENT)) + 255) >> 8; } } const bf16* Yh = WSP(bf16, WS_XS); const bf16* YLP = WSP(bf16, WS_YLP);
                const int bq = gw >> 8, wq = gw & 255; f32x4 g2v[4], fgv[4];
#pragma unroll
                for (int j = 0; j < 4; ++j) { const int c = 4 * lane + 256 * j; g2v[j] = *(const f32x4*)(modl + bq * 6144 + 5120 + c); fgv[j] = *(const f32x4*)(final_norm_g + c); }
                for (int it = 0; it < 2; ++it) {
                    int s0[4], s1[4]; float g0[4], g1[4];
#pragma unroll
                    for (int k = 0; k < 4; ++k) { const int row = bq * 2048 + (it * 4 + k) * 256 + wq; const int ee = RE[row], e0 = ee & 255, e1 = ee >> 8; int tb0 = 0, tb1 = 0;
#pragma unroll
                        for (int e = 0; e < 8; ++e) { tb0 = (e == e0) ? tbA[e] : tb0; tb1 = (e == e1) ? tbA[e] : tb1; }
                        s0[k] = tb0 * 256 + RP[row * 2]; s1[k] = tb1 * 256 + RP[row * 2 + 1]; g0[k] = RG[row * 2]; g1[k] = RG[row * 2 + 1]; }
                    v2u y0[4][4], y1[4][4], xw[4][4];
#pragma unroll
                    for (int k = 0; k < 4; ++k) { const int row = bq * 2048 + (it * 4 + k) * 256 + wq; const int c0 = s0[k] < 128 * 256 ? s0[k] : 0, c1 = s1[k] < 128 * 256 ? s1[k] : 0;
#pragma unroll
                        for (int j = 0; j < 4; ++j) { const int c = 4 * lane + 256 * j;
                            y0[k][j] = __builtin_nontemporal_load((const v2u*)(Yh + (size_t)c0 * D + c)); y1[k][j] = __builtin_nontemporal_load((const v2u*)(Yh + (size_t)c1 * D + c));
                            xw[k][j] = __builtin_nontemporal_load((const v2u*)(XS16 + (size_t)row * D + c)); } }
#pragma unroll
                    for (int k = 0; k < 4; ++k) { const int row = bq * 2048 + (it * 4 + k) * 256 + wq;
                        f32x4 v[4]; float ss = 0.f;
#pragma unroll
                        for (int j = 0; j < 4; ++j) { const int c = 4 * lane + 256 * j;
                            f32x4 ya = {bflo(y0[k][j].x), bfhi(y0[k][j].x), bflo(y0[k][j].y), bfhi(y0[k][j].y)}, yb = {bflo(y1[k][j].x), bfhi(y1[k][j].x), bflo(y1[k][j].y), bfhi(y1[k][j].y)};
                            if (s0[k] >= 128 * 256) { ya = (f32x4){0.f, 0.f, 0.f, 0.f};
#pragma unroll
                                for (int k4 = 0; k4 < 7; ++k4) { const v2u t = *(const v2u*)(YLP + ((size_t)k4 * 2048 + (s0[k] - 128 * 256)) * D + c); ya += (f32x4){bflo(t.x), bfhi(t.x), bflo(t.y), bfhi(t.y)}; } }
                            if (s1[k] >= 128 * 256) { yb = (f32x4){0.f, 0.f, 0.f, 0.f};
#pragma unroll
                                for (int k4 = 0; k4 < 7; ++k4) { const v2u t = *(const v2u*)(YLP + ((size_t)k4 * 2048 + (s1[k] - 128 * 256)) * D + c); yb += (f32x4){bflo(t.x), bfhi(t.x), bflo(t.y), bfhi(t.y)}; } }
                            const f32x4 xv = {bflo(xw[k][j].x), bfhi(xw[k][j].x), bflo(xw[k][j].y), bfhi(xw[k][j].y)}, g2 = g2v[j];
                            const f32x4 y = ya * g0[k] + yb * g1[k];
                            v[j] = xv + g2 * y; ss += (v[j].x * v[j].x + v[j].y * v[j].y) + (v[j].z * v[j].z + v[j].w * v[j].w); }
                        const float rstd = rsqrtf(wave_sum(ss) * (1.f / D) + EPS);
#pragma unroll
                        for (int j = 0; j < 4; ++j) { const int c = 4 * lane + 256 * j; __builtin_nontemporal_store(v[j] * rstd * fgv[j], (f32x4*)(xs + (size_t)row * D + c)); } }
                }
            PH_END
        }
    }

__global__ void __launch_bounds__(NWAVES * 64, 2) fwd(Args args_unused) {
    extern __shared__ __attribute__((aligned(16))) unsigned char lds_raw[];
    LAS unsigned char* lds = (LAS unsigned char*)lds_raw;
    for (int u = threadIdx.x; u < (LDS_BYTES - LDSCTL_OFF) / 4; u += NWAVES * 64) ((LAS unsigned*)(lds + LDSCTL_OFF))[u] = 0u;
    __syncthreads();
    XcdBarrier bar; bar.bar = nullptr; bar.x = 0; bar.st = nullptr;
    if (MK_ONE_LAUNCH) { const kptr_t ka = kargs(); bar = xcd_barrier_post((unsigned*)(KWS + WS_CTL) + CW_BAR, (volatile LAS unsigned*)(lds + MISC_OFF) + 8); }

    PH_BEGIN(0)
        LAS float* scr = (LAS float*)(lds + wave * 16384);
        const float* w_in = KIN(8); const float* w_out = KIN(9);
        if (bx >= 192) {
        const int gw = (bx - 192) * NWAVES + wave, NGW = 64 * NWAVES, gtid = (bx - 192) * (NWAVES * 64) + tid, NGT = 64 * NWAVES * 64;
        dense_convert_range(0, DI_IN, gw, NGW, w_in, w_out, KIN(17), KIN(18), KIN(19), ws, scr, lane);
        { bf16* WTIN = WSP(bf16, WS_WTIN);
          for (int i = gtid; i < 2 * 256 * D; i += NGT) { const int l = i / (256 * D), j = (i / D) & 255, k = i % D; const int oc = j < 32 ? 768 + j : 1824 + (j - 32);
            WTIN[(size_t)l * NPG * D + (size_t)(NP + j) * D + k] = j < NG ? (bf16)f2bf(w_in[(size_t)l * D * D_IN + (size_t)k * D_IN + oc]) : (bf16)0; } }
        { bf16* TWCH = WSP(bf16, WS_TWCH);
          for (int i = gtid; i < 128 * 64; i += NGT) { const int np = i >> 6, c = i & 63, m = np & 63; const float ang = (float)((m * c) & 63) * (6.283185307179586f / 64.f);
            TWCH[i] = (bf16)f2bf(np < 64 ? __cosf(ang) : -__sinf(ang)); } }
        }
        __syncthreads();
        if (bx < 192) {
            const float* c_in = KIN(1); const float* cctx_in = KIN(3); const float* w_ada = KIN(4); const float* b_ada = KIN(5); float* MOD = WSP(float, WS_MOD);
            LAS float* sil = (LAS float*)lds; LAS float* red = (LAS float*)(lds + 36864);
            for (int i = tid; i < 9 * D; i += NWAVES * 64) { const int b = i >> 10, k = i & 1023; const float v = b < 8 ? c_in[b * D + k] : cctx_in[k]; sil[i] = siluf_(v); }
            __syncthreads();
            const int l = bx / 96, col = (bx % 96) * 64 + lane;
            const float* W = w_ada + (size_t)l * D * 6144 + col;
            float acc[9];
#pragma unroll
            for (int b = 0; b < 9; ++b) acc[b] = 0.f;
            for (int k0 = wave * 128; k0 < wave * 128 + 128; k0 += 16) { float w[16];
#pragma unroll
                for (int kk = 0; kk < 16; ++kk) w[kk] = __builtin_nontemporal_load(W + (size_t)(k0 + kk) * 6144);
#pragma unroll 4
                for (int kk = 0; kk < 16; ++kk)
#pragma unroll
                    for (int b = 0; b < 9; ++b) acc[b] += sil[b * D + k0 + kk] * w[kk]; }
#pragma unroll
            for (int b = 0; b < 9; ++b) red[(wave * 9 + b) * 64 + lane] = acc[b];
            __syncthreads();
            if (wave == 0) {
#pragma unroll
                for (int b = 0; b < 9; ++b) { float s = b_ada[l * 6144 + col];
#pragma unroll
                    for (int w = 0; w < 8; ++w) s += red[(w * 9 + b) * 64 + lane];
                    MOD[(size_t)(l * 9 + b) * 6144 + col] = s; } }
            __syncthreads();
        }
    PH_END
    SEAM(0)

    layer_phases<0>(lds, bar);
    layer_phases<1>(lds, bar);
}

extern "C" void kernel_launch(void* const* d_in, const int* in_sizes, int n_in, void* d_out, int out_size, void* d_ws, size_t ws_size, hipStream_t stream) {
    static int grid = 0;
    if (grid == 0) {
        if (n_in != 25 || out_size != MX * D || ws_size < WS_END) { fprintf(stderr, "kernel_launch: unexpected problem (n_in %d out %d ws %zu need %zu)\n", n_in, out_size, ws_size, (size_t)WS_END); grid = -1; return; }
        int dev = 0, cus = 0, per_cu = 0;
        if (hipGetDevice(&dev) != hipSuccess || hipDeviceGetAttribute(&cus, hipDeviceAttributeMultiprocessorCount, dev) != hipSuccess) { grid = -1; return; }
        if (hipFuncSetAttribute((const void*)fwd, hipFuncAttributeMaxDynamicSharedMemorySize, LDS_BYTES) != hipSuccess) { grid = -1; return; }
        if (hipOccupancyMaxActiveBlocksPerMultiprocessor(&per_cu, (const void*)fwd, NWAVES * 64, LDS_BYTES) != hipSuccess || per_cu < 1) { fprintf(stderr, "kernel_launch: occupancy query says %d\n", per_cu); }
        (void)hipGetLastError();
        grid = cus;
        if (grid != 256) { fprintf(stderr, "kernel_launch: built for 256 CUs, got %d\n", grid); grid = -1; return; }
    }
    if (grid < 0) return;
    if (hipMemsetAsync((char*)d_ws + WS_CTL, 0, CTL_ZERO_BYTES, stream) != hipSuccess) return;
    Args a{};
    for (int i = 0; i < 25; ++i) a.in[i] = (const float*)d_in[i];
    a.out = (float*)d_out; a.ws = (unsigned char*)d_ws;
    constexpr int NPH = 33;
    a.submask = -1; a.pad = 0;
#if MK_ONE_LAUNCH
    a.ph_lo = 0; a.ph_hi = NPH;
    hipLaunchKernelGGL(fwd, dim3(grid), dim3(NWAVES * 64), LDS_BYTES, stream, a);
#else
    for (int p = 0; p < NPH; ++p) {
        if (p >= 10 && p <= 16) continue;
        if (p >= 32) continue;
        a.ph_lo = p; a.ph_hi = p + 1; a.submask = -1;
        hipLaunchKernelGGL(fwd, dim3(grid), dim3(NWAVES * 64), LDS_BYTES, stream, a);
#ifdef PROBE_PH
        if (p == PROBE_PH) { a.submask = PROBE_SUBMASK; for (int k = 0; k < PROBE_REPS; ++k) hipLaunchKernelGGL(fwd, dim3(grid), dim3(NWAVES * 64), LDS_BYTES, stream, a); }
#endif
    }
#endif
}
```
